# Optimizing an MI355X kernel written in HIP

```python
import jax, jax.numpy as jnp
from jax import lax
import numpy as np

D_MODEL = 2048
BATCH = 4
SEQ = 4096
DEPTH = 1

HEAD_DIM = 128
POOL_WINDOWS = (2, 4, 8, 16)
POOL_GROUPS = 4
POOL_GROUP_DIM = D_MODEL // 16
POOL_WIDTH = POOL_GROUPS * POOL_GROUP_DIM
ATTN_Q_HEADS = 8
ATTN_KV_HEADS = 2
ATTN_GROUP = ATTN_Q_HEADS // ATTN_KV_HEADS
WINDOW = 128
ATTN_BLOCK = 128
MEM_HEADS = 4
MEM_LEN = 256
N_BRANCHES = 3
N_EXPERTS = 32
TOP_K = 4
D_FF = D_MODEL
SWIGLU_LIMIT = 7.0
SWIGLU_ALPHA = 1.702
MOE_BLOCK = 256
ROPE_THETA = 10000.0
NORM_EPS = 1e-6
NEG_INF = -1e30

Q_WIDTH = ATTN_Q_HEADS * HEAD_DIM
KV_WIDTH = ATTN_KV_HEADS * HEAD_DIM
MEMQ_WIDTH = MEM_HEADS * HEAD_DIM
GATE_WIDTH = N_BRANCHES * D_MODEL
IN_WIDTH = POOL_WIDTH + Q_WIDTH + 2 * KV_WIDTH + MEMQ_WIDTH + GATE_WIDTH

kernel_name = 'hybrid_pool_localgqa_memxattn_moe'


def rms_norm(x, gain):
    xf = x.astype(jnp.float32)
    y = xf * lax.rsqrt(jnp.mean(xf * xf, axis=-1, keepdims=True) + NORM_EPS)
    return (y * gain.astype(jnp.float32)).astype(x.dtype)


def rope(x, positions):
    half = HEAD_DIM // 2
    inv_freq = jnp.power(jnp.float32(ROPE_THETA), -jnp.arange(half, dtype=jnp.float32) * (2.0 / HEAD_DIM))
    ang = positions.astype(jnp.float32)[..., None] * inv_freq
    cos = jnp.cos(ang)[:, :, None, :]
    sin = jnp.sin(ang)[:, :, None, :]
    xf = x.astype(jnp.float32)
    x1, x2 = xf[..., :half], xf[..., half:]
    return jnp.concatenate([x1 * cos - x2 * sin, x2 * cos + x1 * sin], axis=-1).astype(x.dtype)


def multiscale_pool(u):
    bsz, seq, _ = u.shape
    ug = u.reshape(bsz, seq, POOL_GROUPS, POOL_GROUP_DIM).astype(jnp.float32)
    cs = jnp.concatenate([jnp.zeros((bsz, 1, POOL_GROUPS, POOL_GROUP_DIM), jnp.float32),
                          jnp.cumsum(ug, axis=1)], axis=1)
    pos = jnp.arange(seq, dtype=jnp.int32)
    means = []
    for gi, w in enumerate(POOL_WINDOWS):
        lo = jnp.clip(pos - w // 2, 0, seq)
        hi = jnp.clip(pos - w // 2 + w, 0, seq)
        win_sum = cs[:, hi, gi] - cs[:, lo, gi]
        cnt = (hi - lo).astype(jnp.float32)
        means.append(win_sum / cnt[None, :, None])
    pooled = jnp.stack(means, axis=2)
    return (pooled - ug).astype(u.dtype)


def local_gqa(q, k, v, sink):
    bsz, seq = q.shape[0], q.shape[1]
    nb = seq // ATTN_BLOCK
    qb = q.reshape(bsz, nb, ATTN_BLOCK, ATTN_KV_HEADS, ATTN_GROUP, HEAD_DIM)

    def band(t):
        tb = t.reshape(bsz, nb, ATTN_BLOCK, ATTN_KV_HEADS, HEAD_DIM)
        tp = jnp.pad(tb, ((0, 0), (1, 1), (0, 0), (0, 0), (0, 0)))
        return jnp.concatenate([tp[:, :-2], tp[:, 1:-1], tp[:, 2:]], axis=2)

    kw, vw = band(k), band(v)
    scale = 1.0 / np.sqrt(HEAD_DIM)
    s = jnp.einsum('bnqkgd,bnjkd->bnkgqj', qb, kw).astype(jnp.float32) * scale
    qi = jnp.arange(ATTN_BLOCK)[:, None] + ATTN_BLOCK
    kj = jnp.arange(3 * ATTN_BLOCK)[None, :]
    in_band = jnp.abs(kj - qi) <= WINDOW
    key_abs = (jnp.arange(nb)[:, None] - 1) * ATTN_BLOCK + jnp.arange(3 * ATTN_BLOCK)[None, :]
    valid = (key_abs >= 0) & (key_abs < seq)
    mask = in_band[None, :, :] & valid[:, None, :]
    s = jnp.where(mask[None, :, None, None], s, NEG_INF)
    sk = sink.astype(jnp.float32).reshape(ATTN_KV_HEADS, ATTN_GROUP)[None, None, :, :, None, None]
    m = jnp.maximum(jnp.max(s, axis=-1, keepdims=True), sk)
    p = jnp.exp(s - m)
    denom = jnp.sum(p, axis=-1, keepdims=True) + jnp.exp(sk - m)
    probs = (p / denom).astype(v.dtype)
    o = jnp.einsum('bnkgqj,bnjkd->bnqkgd', probs, vw)
    return o.reshape(bsz, seq, ATTN_Q_HEADS * HEAD_DIM)


def memory_attention(q, k, v):
    scale = 1.0 / np.sqrt(HEAD_DIM)
    s = jnp.einsum('bshd,bmhd->bhsm', q, k).astype(jnp.float32) * scale
    probs = jax.nn.softmax(s, axis=-1).astype(v.dtype)
    o = jnp.einsum('bhsm,bmhd->bshd', probs, v)
    return o.reshape(q.shape[0], q.shape[1], MEMQ_WIDTH)


def moe_ffn(xn, l, w_router, b_router, w_up, b_up, w_down, b_down):
    bsz, seq, d = xn.shape
    n_tok = bsz * seq
    n_assign = n_tok * TOP_K
    xt = xn.reshape(n_tok, d)
    logits = jnp.dot(xt, w_router[l]).astype(jnp.float32) + b_router[l].astype(jnp.float32)
    top_logits, top_idx = lax.top_k(logits, TOP_K)
    top_w = jax.nn.softmax(top_logits, axis=-1)
    e_flat = top_idx.reshape(-1).astype(jnp.int32)
    t_flat = jnp.arange(n_assign, dtype=jnp.int32) // TOP_K
    g_flat = top_w.reshape(-1)
    order = jnp.argsort(e_flat, stable=True)
    e_s, t_s, g_s = e_flat[order], t_flat[order], g_flat[order]
    counts = jnp.bincount(e_flat, length=N_EXPERTS).astype(jnp.int32)
    starts = jnp.cumsum(counts) - counts
    padded = (counts + MOE_BLOCK - 1) // MOE_BLOCK * MOE_BLOCK
    pad_ends = jnp.cumsum(padded)
    pad_starts = pad_ends - padded
    dest = pad_starts[e_s] + (jnp.arange(n_assign, dtype=jnp.int32) - starts[e_s])
    n_blocks = -(-n_assign // MOE_BLOCK) + N_EXPERTS
    cap = n_blocks * MOE_BLOCK
    tok_buf = jnp.zeros((cap,), jnp.int32).at[dest].set(t_s)
    gate_buf = jnp.zeros((cap,), jnp.float32).at[dest].set(g_s)
    blk_start = jnp.arange(n_blocks, dtype=jnp.int32) * MOE_BLOCK
    blk_expert = jnp.minimum(jnp.searchsorted(pad_ends, blk_start, side='right'),
                             N_EXPERTS - 1).astype(jnp.int32)

    def expert_block(args):
        tok, e = args
        xb = xt[tok]
        hb = jnp.dot(xb, w_up[l, e]) + b_up[l, e]
        gate = jnp.minimum(hb[:, 0::2], SWIGLU_LIMIT)
        up = jnp.clip(hb[:, 1::2], -SWIGLU_LIMIT, SWIGLU_LIMIT)
        act = gate * jax.nn.sigmoid(SWIGLU_ALPHA * gate) * (up + 1.0)
        return jnp.dot(act, w_down[l, e]) + b_down[l, e]

    y_buf = lax.map(expert_block, (tok_buf.reshape(n_blocks, MOE_BLOCK), blk_expert))
    y = jnp.zeros((n_tok, d), jnp.float32).at[tok_buf].add(
        y_buf.reshape(cap, d).astype(jnp.float32) * gate_buf[:, None])
    return y.reshape(bsz, seq, d).astype(xn.dtype)


def setup_inputs(seed: int = 0) -> dict:
    key = jax.random.key(seed)
    ks = jax.random.split(key, 32)
    f32 = jnp.float32
    L, D = DEPTH, D_MODEL

    def nrm(k, shape, fan_in):
        return jax.random.normal(k, shape, f32) * (fan_in ** -0.5)

    def gain(k, shape):
        return 1.0 + 0.05 * jax.random.normal(k, shape, f32)

    x = jax.random.normal(ks[0], (BATCH, SEQ, D), f32)
    mem = jax.random.normal(ks[1], (BATCH, MEM_LEN, D), f32)
    offsets = jax.random.randint(ks[2], (BATCH, 1), 0, 1024, dtype=jnp.int32)
    positions = offsets + jnp.arange(SEQ, dtype=jnp.int32)[None, :]
    return {
        'x': x,
        'mem': mem,
        'positions': positions,
        'norm1_gain': gain(ks[3], (L, D)),
        'w_in': nrm(ks[4], (L, D, IN_WIDTH), D),
        'b_gate': 0.1 * jax.random.normal(ks[5], (L, GATE_WIDTH), f32),
        'w_pool_group': nrm(ks[6], (L, POOL_GROUPS, POOL_GROUP_DIM, POOL_GROUP_DIM), POOL_GROUP_DIM),
        'pool_scale': gain(ks[7], (L, POOL_WIDTH)),
        'w_pool_proj': nrm(ks[8], (L, POOL_WIDTH, D), POOL_WIDTH),
        'attn_q_norm': gain(ks[9], (L, HEAD_DIM)),
        'attn_k_norm': gain(ks[10], (L, HEAD_DIM)),
        'attn_sink': 0.5 * jax.random.normal(ks[11], (L, ATTN_Q_HEADS), f32),
        'w_attn_proj': nrm(ks[12], (L, Q_WIDTH, D), Q_WIDTH),
        'mem_norm_gain': gain(ks[13], (L, D)),
        'w_mem_kv': nrm(ks[14], (L, D, 2 * MEMQ_WIDTH), D),
        'mem_q_norm': gain(ks[15], (L, HEAD_DIM)),
        'mem_k_norm': gain(ks[16], (L, HEAD_DIM)),
        'w_mem_proj': nrm(ks[17], (L, MEMQ_WIDTH, D), MEMQ_WIDTH),
        'w_out': nrm(ks[18], (L, D, D), D),
        'norm2_gain': gain(ks[19], (L, D)),
        'w_router': nrm(ks[20], (L, D, N_EXPERTS), D),
        'b_router': 0.01 * jax.random.normal(ks[21], (L, N_EXPERTS), f32),
        'w_up': nrm(ks[22], (L, N_EXPERTS, D, 2 * D_FF), D),
        'b_up': 0.02 * jax.random.normal(ks[23], (L, N_EXPERTS, 2 * D_FF), f32),
        'w_down': nrm(ks[24], (L, N_EXPERTS, D_FF, D), D_FF),
        'b_down': 0.02 * jax.random.normal(ks[25], (L, N_EXPERTS, D), f32),
    }


def reference(x, mem, positions, norm1_gain, w_in, b_gate, w_pool_group, pool_scale, w_pool_proj,
              attn_q_norm, attn_k_norm, attn_sink, w_attn_proj, mem_norm_gain, w_mem_kv,
              mem_q_norm, mem_k_norm, w_mem_proj, w_out, norm2_gain, w_router, b_router,
              w_up, b_up, w_down, b_down):
    bsz, seq, d = x.shape
    n_mem = mem.shape[1]
    h = x
    for l in range(DEPTH):
        xn = rms_norm(h, norm1_gain[l])
        proj = jnp.dot(xn, w_in[l])
        o0 = 0
        u_pool = proj[..., o0:o0 + POOL_WIDTH]; o0 += POOL_WIDTH
        u_q = proj[..., o0:o0 + Q_WIDTH]; o0 += Q_WIDTH
        u_k = proj[..., o0:o0 + KV_WIDTH]; o0 += KV_WIDTH
        u_v = proj[..., o0:o0 + KV_WIDTH]; o0 += KV_WIDTH
        u_mq = proj[..., o0:o0 + MEMQ_WIDTH]; o0 += MEMQ_WIDTH
        u_gate = proj[..., o0:o0 + GATE_WIDTH]

        pooled = multiscale_pool(u_pool)
        a = jnp.einsum('bsgc,gcd->bsgd', pooled, w_pool_group[l]).reshape(bsz, seq, POOL_WIDTH)
        br_a = jnp.dot(a * pool_scale[l], w_pool_proj[l])

        q = u_q.reshape(bsz, seq, ATTN_Q_HEADS, HEAD_DIM)
        k = u_k.reshape(bsz, seq, ATTN_KV_HEADS, HEAD_DIM)
        v = u_v.reshape(bsz, seq, ATTN_KV_HEADS, HEAD_DIM)
        q = rope(rms_norm(q, attn_q_norm[l]), positions)
        k = rope(rms_norm(k, attn_k_norm[l]), positions)
        br_b = jnp.dot(local_gqa(q, k, v, attn_sink[l]), w_attn_proj[l])

        mn = rms_norm(mem, mem_norm_gain[l])
        kv = jnp.dot(mn, w_mem_kv[l]).reshape(bsz, n_mem, 2, MEM_HEADS, HEAD_DIM)
        mk = rms_norm(kv[:, :, 0], mem_k_norm[l])
        mv = kv[:, :, 1]
        mq = rms_norm(u_mq.reshape(bsz, seq, MEM_HEADS, HEAD_DIM), mem_q_norm[l])
        br_c = jnp.dot(memory_attention(mq, mk, mv), w_mem_proj[l])

        g = jax.nn.sigmoid((u_gate + b_gate[l]).astype(jnp.float32)).astype(h.dtype)
        g = g.reshape(bsz, seq, N_BRANCHES, d)
        merged = g[:, :, 0] * br_a + g[:, :, 1] * br_b + g[:, :, 2] * br_c
        h = h + jnp.dot(merged, w_out[l])

        h = h + moe_ffn(rms_norm(h, norm2_gain[l]), l, w_router, b_router, w_up, b_up, w_down, b_down)
    return h
```

```cpp
#include <hip/hip_runtime.h>
#include <cstdio>
#include <cstdint>

#ifndef MK_SPLIT
#define MK_SPLIT 0
#endif

#define GAS __attribute__((address_space(1)))
#define LAS __attribute__((address_space(3)))
typedef unsigned short bf16_t;
typedef short bf16x8 __attribute__((ext_vector_type(8)));
typedef float f32x2 __attribute__((ext_vector_type(2)));
typedef float f32x4 __attribute__((ext_vector_type(4)));
typedef float f32x16 __attribute__((ext_vector_type(16)));
typedef unsigned u32x2 __attribute__((ext_vector_type(2)));
typedef unsigned u32x4 __attribute__((ext_vector_type(4)));
typedef __bf16 bf16x2v __attribute__((ext_vector_type(2)));
typedef int i32x4 __attribute__((ext_vector_type(4)));
typedef int i32x8 __attribute__((ext_vector_type(8)));

constexpr int D = 2048, NBATCH = 4, SEQ = 4096, NTOK = NBATCH * SEQ;
constexpr int IN_W = 8704, OFF_POOL = 0, OFF_Q = 512, OFF_K = 1536, OFF_V = 1792, OFF_MQ = 2048, OFF_GATE = 2560;
constexpr int MEMLEN = 256, NMEMROW = NBATCH * MEMLEN;
constexpr int NE = 32, DFF = 2048, CAP = NTOK, NSLOT = NTOK * 4 + NE * 256, MAXMB = NSLOT / 256;
constexpr float NORM_EPS = 1e-6f;
#ifndef MOE_FP8
#define MOE_FP8 1
#endif
constexpr int MOE_EB = MOE_FP8 ? 1 : 2;
constexpr float MOE_WSCALE = MOE_FP8 ? 64.0f : 1.0f;
#ifndef MK_BAR_TWICE
#define MK_BAR_TWICE 0
#endif
#ifndef MK_DMA_EXTRA
#define MK_DMA_EXTRA 0
#endif
#ifndef MK_LDS_EXTRA
#define MK_LDS_EXTRA 0
#endif
#ifndef MK_MFMA_TWICE
#define MK_MFMA_TWICE 0
#endif
#ifndef MK_EPI_TWICE
#define MK_EPI_TWICE 0
#endif
#ifndef MOE_PROBE
#define MOE_PROBE 0
#endif
#ifndef P1_FP8_TILES
#define P1_FP8_TILES 16
#endif
#ifndef GATE_BC_FP8
#define GATE_BC_FP8 1
#endif
#ifndef MOE_WGM
#define MOE_WGM 4
#endif
#ifndef MOE_WGM_DN
#define MOE_WGM_DN 8
#endif
#ifndef XN2_PREGATHER
#define XN2_PREGATHER 1
#endif
#ifndef ACT_KTILE_MAJOR
#define ACT_KTILE_MAJOR 1
#endif
#ifndef MOE_W_KTILE_MAJOR
#define MOE_W_KTILE_MAJOR 1
#endif
#ifndef P4_SMALL_FIRST
#define P4_SMALL_FIRST 1
#endif
#ifndef P4_SCR_BF16
#define P4_SCR_BF16 1
#endif
#ifndef H1_BF16
#define H1_BF16 1
#endif
#ifndef YBUF_FP8
#define YBUF_FP8 1
#endif
#ifndef P1_QKV_FP8
#define P1_QKV_FP8 1
#endif
#ifndef P4_FP8
#define P4_FP8 1
#endif
#ifndef MOE_STAG_GROUPS
#define MOE_STAG_GROUPS 4
#define MOE_STAG_STEP 1
#endif
#ifndef MOE_CONV_IN_P1
#define MOE_CONV_IN_P1 1
#endif
constexpr float LOG2E = 1.4426950408889634f;
constexpr float QSCALE = 0.08838834764831845f * 1.4426950408889634f;

constexpr int P1_NF8 = P1_FP8_TILES + (P1_QKV_FP8 ? 8 : 0), P1_NBF = 34 - P1_NF8;
__host__ __device__ constexpr int p1_tile_bf(int b) { return P1_QKV_FP8 ? (b < 2 ? b : b + 8) : b; }
__host__ __device__ constexpr int p1_tile_f8(int f) { return P1_QKV_FP8 ? (f < 8 ? f + 2 : f + 10) : 34 - P1_FP8_TILES + f; }
__host__ __device__ constexpr int p1_f8_index(int pn) { return P1_QKV_FP8 ? (pn < 10 ? pn - 2 : pn - 10) : pn - (34 - P1_FP8_TILES); }
static_assert(!MOE_W_KTILE_MAJOR || MOE_FP8, "the k-tile-major weight layout is written for fp8 (128 k = 128 bytes)");
static_assert(!ACT_KTILE_MAJOR || MOE_FP8, "the k-tile-major activation layout is written for fp8");
constexpr size_t al256(size_t x) { return (x + 255) & ~(size_t)255; }
constexpr size_t WS_CTL = 0, CTL_BYTES = 1u << 20;
constexpr size_t WS_WIN_T = WS_CTL + CTL_BYTES;
constexpr size_t WS_WCAT_T = WS_WIN_T + (size_t)IN_W * D * 2;
constexpr size_t WS_WOUT_T = WS_WCAT_T + (size_t)D * D * 2;
constexpr size_t WS_WMKV_T = WS_WOUT_T + (size_t)D * D * 2;
constexpr size_t WS_WRF = WS_WMKV_T + (size_t)1024 * D * 2;
constexpr size_t WS_WUP_T = WS_WRF + (size_t)D * NE * 4;
constexpr size_t WS_WDN_T = WS_WUP_T + (size_t)NE * 2 * DFF * D * 2;
constexpr size_t WS_XN = WS_WDN_T + (size_t)NE * D * DFF * 2;
constexpr size_t WS_MN = WS_XN + (size_t)NTOK * D * 2;
constexpr size_t WS_PROJ = WS_MN + (size_t)NMEMROW * D * 2;
constexpr size_t WS_KVRAW = WS_PROJ + (size_t)NTOK * IN_W * 2;
constexpr size_t WS_QN = WS_KVRAW + (size_t)NMEMROW * 1024 * 2;
constexpr size_t WS_KN = WS_QN + (size_t)NTOK * 1024 * 2;
constexpr size_t WS_VT = WS_KN + (size_t)NTOK * 256 * 2;
constexpr size_t WS_MQN = WS_VT + (size_t)NTOK * 256 * 2;
constexpr size_t WS_MK = WS_MQN + (size_t)NTOK * 512 * 2;
constexpr size_t WS_MVT = WS_MK + (size_t)NMEMROW * 512 * 2;
constexpr size_t WS_ACAT = WS_MVT + (size_t)NMEMROW * 512 * 2;
constexpr size_t WS_MSCR = WS_ACAT + (size_t)NTOK * D * 2;
constexpr size_t WS_MERGED = WS_MSCR + (size_t)NTOK * D * 4;
constexpr size_t WS_XN2 = WS_MERGED + (size_t)NTOK * D * 2;
constexpr size_t WS_LIST = WS_XN2 + (size_t)NTOK * D * 2;
constexpr size_t WS_ER = WS_LIST + (size_t)NE * CAP * 4;
constexpr size_t WS_TW = WS_ER + (size_t)NTOK * 4 * 4;
constexpr size_t WS_ACT = WS_TW + (size_t)NTOK * 4 * 4;
constexpr size_t WS_YBUF = WS_ACT + (size_t)NSLOT * DFF * 2;
constexpr size_t WS_XN8 = WS_YBUF + (size_t)NSLOT * D * 2;
constexpr size_t WS_WIN8 = WS_XN8 + (size_t)NTOK * D;
constexpr size_t WS_ACAT8 = WS_WIN8 + (size_t)24 * 256 * D;
constexpr size_t WS_WCAT8 = WS_ACAT8 + (size_t)NTOK * 1536;
constexpr size_t WS_WRH = WS_WCAT8 + (size_t)D * 1536;
constexpr size_t WS_WRL = WS_WRH + (size_t)NE * D * 2;
constexpr size_t WS_H1B = WS_WRL + (size_t)NE * D * 2;
constexpr size_t WS_GATE8 = WS_H1B + (size_t)NTOK * D * 2;
constexpr size_t WS_XG = WS_GATE8 + (size_t)NTOK * 2 * D;
constexpr size_t WS_END = WS_XG + (XN2_PREGATHER ? (size_t)NE * 16 * CAP * 128 : 0);
constexpr int CW_BAR = 4096;
constexpr int CW_CNT = 16384;

constexpr int RING_BYTES = 131072, MISC_OFF = 133120  , LDS_BYTES = MISC_OFF + 8192 + (MK_DMA_EXTRA ? 8192 : 0);
constexpr int L_CNT = MISC_OFF + 64, L_MBST = MISC_OFF + 256, L_NMB = MISC_OFF + 448, L_MBE = MISC_OFF + 512, L_MBR0 = MISC_OFF + 2048;

__device__ __forceinline__ unsigned pk2(float lo, float hi) { f32x2 v = {lo, hi}; return __builtin_bit_cast(unsigned, __builtin_convertvector(v, bf16x2v)); }
__device__ __forceinline__ float bflo(unsigned w) { return __uint_as_float(w << 16); }
__device__ __forceinline__ float bfhi(unsigned w) { return __uint_as_float(w & 0xffff0000u); }
__device__ __forceinline__ float bf2f(bf16_t b) { return __uint_as_float((unsigned)b << 16); }
__device__ __forceinline__ bf16_t f2bf(float f) { return (bf16_t)(pk2(f, 0.f) & 0xffffu); }
__device__ __forceinline__ float wave_sum(float v) {
#pragma unroll
    for (int o = 1; o < 64; o <<= 1) v += __shfl_xor(v, o);
    return v;
}
__device__ __forceinline__ float fast_sigmoid(float x) { return __builtin_amdgcn_rcpf(1.0f + __builtin_amdgcn_exp2f(-LOG2E * x)); }
#define LDS_WAIT() asm volatile("s_waitcnt lgkmcnt(0)" ::: "memory")

#define XB_TMO      128
#define XB_XCNT(j)  (256  + 64 * (j))
#define XB_XSUB(j)  (1280 + 64 * (j))
#define XB_XGEN(j)  (2304 + 64 * (j))
#define XB_TOP      3328
#define XB_TOPGEN   3392
#define XCD_BAR_WORDS 3456
#define XB_SPIN_CAP (1u << 18)
__device__ __forceinline__ unsigned xb_ld(unsigned* p)              { return __hip_atomic_load(p, __ATOMIC_RELAXED, __HIP_MEMORY_SCOPE_AGENT); }
__device__ __forceinline__ unsigned xb_add(unsigned* p, unsigned v) { return __hip_atomic_fetch_add(p, v, __ATOMIC_RELAXED, __HIP_MEMORY_SCOPE_AGENT); }
__device__ __forceinline__ unsigned xb_xcc_id() { return (unsigned)__builtin_amdgcn_s_getreg((3 << 11) | 20) & 0xFu; }
#define XB_SPIN(cond, bar) do { unsigned _sp = 0; while (cond) { __builtin_amdgcn_s_sleep(1); \
    if ((++_sp & 255u) == 0u) { if (xb_ld(&(bar)[XB_TMO])) break; if (_sp > XB_SPIN_CAP) { atomicAdd(&(bar)[XB_TMO], 1u); break; } } } } while (0)
struct XcdBarrier { unsigned* bar; unsigned x; volatile LAS unsigned* st; };
__device__ __forceinline__ XcdBarrier xcd_barrier_post(unsigned* bar, volatile LAS unsigned* st) {
    XcdBarrier b; b.bar = bar; b.x = xb_xcc_id(); b.st = st;
    if (threadIdx.x == 0) (void)xb_add(&bar[XB_XCNT(b.x)], 1u);
    return b;
}
__device__ __forceinline__ void xcd_barrier_complete(unsigned* bar, unsigned x, unsigned& nloc, unsigned& nx) {
    const unsigned G = gridDim.x * gridDim.y * gridDim.z;
    unsigned sum, cnt, mine, sp = 0u;
    for (;;) {
        sum = 0u; cnt = 0u; mine = 0u;
#pragma unroll
        for (unsigned j = 0; j < 16; ++j) { const unsigned c = xb_ld(&bar[XB_XCNT(j)]); sum += c; cnt += (c > 0u) ? 1u : 0u; mine = (j == x) ? c : mine; }
        if (sum == G) break;
        __builtin_amdgcn_s_sleep(1);
        if ((++sp & 255u) == 0u) { if (xb_ld(&bar[XB_TMO])) break; if (sp > XB_SPIN_CAP) { atomicAdd(&bar[XB_TMO], 1u); break; } }
    }
    nloc = mine > 0u ? mine : 1u; nx = cnt > 0u ? cnt : 1u;
}
__device__ __forceinline__ void xcd_barrier(const XcdBarrier& b) {
    asm volatile("s_waitcnt vmcnt(0)" ::: "memory");
    __syncthreads();
    if (threadIdx.x == 0) {
        unsigned* bar = b.bar;
        __builtin_amdgcn_s_waitcnt(0);
        unsigned nloc = b.st[0], nx = b.st[1];
        if (nloc == 0u) { xcd_barrier_complete(bar, b.x, nloc, nx); b.st[0] = nloc; b.st[1] = nx; }
        const unsigned old = xb_add(&bar[XB_XSUB(b.x)], 1u);
        const unsigned gen = old / nloc;
        if (old + 1u == (gen + 1u) * nloc) {
            __builtin_amdgcn_fence(__ATOMIC_RELEASE, "agent");
            asm volatile("s_waitcnt vmcnt(0)" ::: "memory");
            const unsigned og = xb_add(&bar[XB_TOP], 1u);
            const unsigned tg = og / nx;
            if (og + 1u == (tg + 1u) * nx) xb_add(&bar[XB_TOPGEN], 1u);
            else XB_SPIN(xb_ld(&bar[XB_TOPGEN]) == tg, bar);
            __builtin_amdgcn_fence(__ATOMIC_ACQUIRE, "agent");
            xb_add(&bar[XB_XGEN(b.x)], 1u);
            asm volatile("s_waitcnt vmcnt(0)" ::: "memory");
        } else {
            XB_SPIN(xb_ld(&bar[XB_XGEN(b.x)]) == gen, bar);
            __builtin_amdgcn_fence(__ATOMIC_ACQUIRE, "agent");
            asm volatile("s_waitcnt vmcnt(0)" ::: "memory");
        }
    }
    __syncthreads();
}

namespace pg8 {
constexpr int BM = 256, BK = 64, HALF = 128, HTB = HALF * BK * 2, STAGE_BYTES = 8 * HTB, NXCD = 8, WGM = 4;
__device__ __forceinline__ int lds_byte(int r, int c) { const int st = (r >> 4) * 2 + (c >> 5), rr = r & 15, cc = c & 31, ob = rr * 64 + cc * 2; return st * 1024 + (ob ^ (((ob >> 9) & 1) << 5)); }
__device__ __forceinline__ void stage_rc(int b, int& R, int& C) { const int st = b / 1024, sb = b % 1024, swz = sb ^ (((sb >> 9) & 1) << 5); R = (st >> 1) * 16 + swz / 64; C = (st & 1) * 32 + (swz % 64) / 2; }
struct Unit { int pm, pn, aux; };
__device__ __forceinline__ void mfma_fp8(f32x4& c, const i32x8 a, const i32x8 b, int sa, int sb) {
    asm volatile("v_mfma_scale_f32_16x16x128_f8f6f4 %0, %1, %2, %0, %3, %4 op_sel_hi:[0,0,0]" : "+v"(c) : "v"(a), "v"(b), "v"(sa), "v"(sb));
}
__device__ __forceinline__ void mfma_fp8_settle() { asm volatile("s_nop 7\n\ts_nop 7\n\ts_nop 7" ::: "memory"); }
__device__ __forceinline__ void tile_of(int L, int nM, int nN, int& pm, int& pn, const int WGM = pg8::WGM) {
    const int nwg = nM * nN; int wgid = L;
    { const int q = nwg / NXCD, r = nwg % NXCD, xcd = wgid % NXCD, off = wgid / NXCD; wgid = (xcd < r ? xcd * (q + 1) : r * (q + 1) + (xcd - r) * q) + off; }
    const int nig = WGM * nN, gid = wgid / nig, fm = gid * WGM, gsz = (nM - fm) < WGM ? (nM - fm) : WGM;
    pm = fm + ((wgid % nig) % gsz); pn = (wgid % nig) / gsz;
}
template <int MODE> __device__ __forceinline__ int brow(int R) { return MODE == 0 ? R : 64 * (R >> 5) + 16 * ((R & 15) >> 2) + 4 * ((R >> 4) & 1) + (R & 3); }

template <class Epi, class Sched>
__device__ __forceinline__ void gemm_phase(LAS unsigned char* lds, const Sched& S, const Epi& E) {
    const int tid = threadIdx.x, wid = __builtin_amdgcn_readfirstlane(tid >> 6), lane = tid & 63, wr = wid >> 2, wc = wid & 3, fr = lane & 15, fq = lane >> 4;
    unsigned voffA[2], voffA1[2], voffB[2]; int gR[2], gC[2];
#pragma unroll
    for (int i = 0; i < 2; ++i) { int R, C; stage_rc(tid * 16 + i * 8192, R, C);
        voffB[i] = (unsigned)(brow<Epi::MODE>(R) * S.ldb + C) * 2u; voffA[i] = (unsigned)(R * S.lda + C) * 2u; voffA1[i] = voffA[i]; gR[i] = R; gC[i] = C * 2; }
    const size_t kstepB = S.kstep_b(), kstep = S.kstep_a();
    const size_t hstepA = (size_t)HALF * S.lda * 2;
    const size_t hstepB = (size_t)(Epi::MODE == 0 ? HALF : 8) * S.ldb * 2;
    const unsigned ldsw = (unsigned)wid * 1024u;
    const int aoff = lds_byte(wr * 64 + fr, fq * 8), boff = lds_byte(wc * 32 + fr, fq * 8);
#define PG8_SA(b, h) (((b) * 2 + (h)) * HTB)
#define PG8_SB(b, h) ((4 + (b) * 2 + (h)) * HTB)
#define PG8_STAGE(bufoff, gbase, voff) do { _Pragma("unroll") for (int _i = 0; _i < 2; ++_i) { unsigned _vo = (voff)[_i]; asm volatile("" : "+v"(_vo)); \
        __builtin_amdgcn_global_load_lds((const unsigned*)((const char*)(gbase) + _vo), (LAS unsigned*)(lds + (bufoff) + ldsw + _i * 8192), 16, 0, 0); } } while (0)
#define PG8_STAGE_A0(bufoff, gbase) PG8_STAGE(bufoff, gbase, voffA)
#define PG8_STAGE_A1(bufoff, gbase) do { if constexpr (Sched::GATHER) { PG8_STAGE(bufoff, gbase, voffA1); } else { PG8_STAGE(bufoff, (gbase) + hstepA, voffA); } } while (0)
#define PG8_LDA(dst, b, h) do { _Pragma("unroll") for (int m = 0; m < 4; ++m) _Pragma("unroll") for (int k = 0; k < 2; ++k) dst[m][k] = *(const LAS bf16x8*)(lds + PG8_SA(b, h) + aoff + m * 2048 + k * 1024); } while (0)
#define PG8_LDB(dst, b, h) do { _Pragma("unroll") for (int n = 0; n < 2; ++n) _Pragma("unroll") for (int k = 0; k < 2; ++k) dst[n][k] = *(const LAS bf16x8*)(lds + PG8_SB(b, h) + boff + n * 2048 + k * 1024); } while (0)
#define PG8_CAT8(x) __builtin_shufflevector(__builtin_bit_cast(i32x4, (x)[0]), __builtin_bit_cast(i32x4, (x)[1]), 0, 1, 2, 3, 4, 5, 6, 7)
#define PG8_MMA(ai, bj, At, Bt) do { __builtin_amdgcn_s_setprio(1); \
        if constexpr (Sched::FP8) { _Pragma("unroll") for (int m = 0; m < 4; ++m) _Pragma("unroll") for (int n = 0; n < 2; ++n) \
            { mfma_fp8(acc[ai][bj][m][n], PG8_CAT8(Bt[n]), PG8_CAT8(At[m]), Sched::SCALE_B, 0x7f7f7f7f); if (MK_MFMA_TWICE) mfma_fp8(dummy_acc[(m * 2 + n) & 3], PG8_CAT8(Bt[n]), PG8_CAT8(At[m]), Sched::SCALE_B, 0x7f7f7f7f); } } \
        else { _Pragma("unroll") for (int m = 0; m < 4; ++m) _Pragma("unroll") for (int n = 0; n < 2; ++n) _Pragma("unroll") for (int k = 0; k < 2; ++k) \
            acc[ai][bj][m][n] = __builtin_amdgcn_mfma_f32_16x16x32_bf16(Bt[n][k], At[m][k], acc[ai][bj][m][n], 0, 0, 0); } \
        __builtin_amdgcn_s_setprio(0); } while (0)
#define PG8_LDX(b, h) do { if constexpr (Sched::FP8 && MK_LDS_EXTRA) { _Pragma("unroll") for (int m = 0; m < 4; ++m) _Pragma("unroll") for (int k = 0; k < 2; ++k) { bf16x8 _d = *(const LAS bf16x8*)(lds + PG8_SA(b, h) + aoff + m * 2048 + k * 1024 + 4096); asm volatile("" :: "v"(_d)); } } } while (0)
#define PG8_DMX(gbase) do { if constexpr (Sched::FP8 && MK_DMA_EXTRA) { unsigned _vo = voffB[0]; asm volatile("" : "+v"(_vo)); \
        __builtin_amdgcn_global_load_lds((const unsigned*)((const char*)(gbase) + _vo), (LAS unsigned*)(lds + MISC_OFF + 8192 + ldsw), 16, 0, 0); } } while (0)
#define PG8_WAIT_V8() do { if constexpr (Sched::FP8 && MK_DMA_EXTRA) asm volatile("s_waitcnt vmcnt(10)" ::: "memory"); else asm volatile("s_waitcnt vmcnt(8)" ::: "memory"); } while (0)
#define PG8_WAIT_V(n) asm volatile("s_waitcnt vmcnt(" #n ")" ::: "memory")
#define PG8_WAIT_L(n) asm volatile("s_waitcnt lgkmcnt(" #n ")" ::: "memory")
#define PG8_BAR __builtin_amdgcn_s_barrier()
#define PG8_SCHED __builtin_amdgcn_sched_barrier(0)
    Unit cur, nxt; int ui = 0; bool side_done = false;
    if (!S.next(0, cur)) { S.side(); return; }
    f32x4 acc[2][2][4][2];
#pragma unroll
    for (int a = 0; a < 2; ++a)
#pragma unroll
        for (int b = 0; b < 2; ++b)
#pragma unroll
            for (int m = 0; m < 4; ++m)
#pragma unroll
                for (int n = 0; n < 2; ++n) acc[a][b][m][n] = (f32x4){0.f, 0.f, 0.f, 0.f};
    bf16x8 At[4][2], B0[2][2], B1[2][2];
    f32x4 dummy_acc[4] = {{0.f, 0.f, 0.f, 0.f}, {0.f, 0.f, 0.f, 0.f}, {0.f, 0.f, 0.f, 0.f}, {0.f, 0.f, 0.f, 0.f}};
    const char* cA = S.a_base(cur); const char* cB = S.b_base(cur); int cnt = S.nt(cur);
    if constexpr (Sched::GATHER) {
#pragma unroll
        for (int i = 0; i < 2; ++i) { voffA[i] = S.gather(cur, gR[i], gC[i]); voffA1[i] = S.gather(cur, gR[i] + HALF, gC[i]); }
    }
    PG8_STAGE(PG8_SB(0, 0), cB, voffB); PG8_STAGE(PG8_SB(0, 1), cB + hstepB, voffB); PG8_STAGE_A0(PG8_SA(0, 0), cA); PG8_STAGE_A1(PG8_SA(0, 1), cA);
    if (wr == 1) PG8_BAR;
    PG8_WAIT_V(2); PG8_BAR;
    PG8_STAGE(PG8_SB(1, 0), cB + kstepB, voffB); PG8_STAGE_A0(PG8_SA(1, 0), cA + kstep); PG8_STAGE(PG8_SB(1, 1), cB + hstepB + kstepB, voffB);
    PG8_WAIT_V(6); PG8_BAR;
    for (;;) {
        const bool has_next = S.next(ui + 1, nxt);
        const char* nA = has_next ? S.a_base(nxt) : cA; const char* nB = has_next ? S.b_base(nxt) : cB;
        const int nt = cnt;
        unsigned gx0[2] = {voffA[0], voffA[1]}, gx1[2] = {voffA1[0], voffA1[1]};
        if constexpr (Sched::GATHER) { if (has_next) {
#pragma unroll
            for (int i = 0; i < 2; ++i) { gx0[i] = S.gather(nxt, gR[i], gC[i]); gx1[i] = S.gather(nxt, gR[i] + HALF, gC[i]); } } }
        for (int t = 0; t < nt; t += 2) {
            const bool last = (t == nt - 2);
            const char* a1 = cA + (size_t)(t + 1) * kstep;
            const char* a2 = last ? nA : cA + (size_t)(t + 2) * kstep; const char* b2 = last ? nB : cB + (size_t)(t + 2) * kstepB;
            const char* a3 = a2 + kstep; const char* b3 = b2 + kstepB;
            unsigned nv0[2] = {voffA[0], voffA[1]}, nv1[2] = {voffA1[0], voffA1[1]};
            if constexpr (Sched::GATHER) { if (last && has_next) { nv0[0] = gx0[0]; nv0[1] = gx0[1]; nv1[0] = gx1[0]; nv1[1] = gx1[1]; } }
            PG8_LDB(B0, 0, 0); PG8_LDB(B1, 0, 1); PG8_SCHED; PG8_LDA(At, 0, 0); PG8_LDX(0, 0); PG8_STAGE_A1(PG8_SA(1, 1), a1);
            if constexpr (Sched::GATHER) { voffA[0] = nv0[0]; voffA[1] = nv0[1]; voffA1[0] = nv1[0]; voffA1[1] = nv1[1]; }
            PG8_DMX(cB); PG8_WAIT_V8(); PG8_WAIT_L(0); PG8_BAR; PG8_MMA(0, 0, At, B0); PG8_MMA(0, 1, At, B1); PG8_BAR; PG8_SCHED;
            PG8_LDA(At, 0, 1); PG8_LDX(0, 1); PG8_STAGE(PG8_SB(0, 0), b2, voffB); PG8_STAGE(PG8_SB(0, 1), b2 + hstepB, voffB); PG8_STAGE_A0(PG8_SA(0, 0), a2);
            PG8_DMX(cB); PG8_WAIT_V8(); PG8_WAIT_L(0); PG8_BAR; PG8_MMA(1, 0, At, B0); PG8_MMA(1, 1, At, B1); PG8_BAR; PG8_SCHED;
            PG8_LDB(B0, 1, 0); PG8_LDB(B1, 1, 1); PG8_SCHED; PG8_LDA(At, 1, 0); PG8_LDX(1, 0); PG8_STAGE_A1(PG8_SA(0, 1), a2);
            PG8_DMX(cB); PG8_WAIT_V8(); PG8_WAIT_L(0); PG8_BAR; PG8_MMA(0, 0, At, B0); PG8_MMA(0, 1, At, B1); PG8_BAR; PG8_SCHED;
            PG8_LDA(At, 1, 1); PG8_LDX(1, 1); PG8_STAGE(PG8_SB(1, 0), b3, voffB); PG8_STAGE(PG8_SB(1, 1), b3 + hstepB, voffB); PG8_STAGE_A0(PG8_SA(1, 0), a3);
            PG8_DMX(cB); PG8_WAIT_V8(); PG8_WAIT_L(0); PG8_BAR; PG8_MMA(1, 0, At, B0); PG8_MMA(1, 1, At, B1); PG8_BAR; PG8_SCHED;
        }
        if (wr == 0) PG8_BAR;
        if constexpr (Sched::FP8) mfma_fp8_settle();
        { const int l2 = (int)__builtin_amdgcn_mbcnt_hi(~0u, __builtin_amdgcn_mbcnt_lo(~0u, 0u)); E(acc, cur, wr, wc, l2 & 15, l2 >> 4);
          if constexpr (Epi::PROBE_TWICE) { asm volatile("s_waitcnt vmcnt(0)" ::: "memory"); E(acc, cur, wr, wc, l2 & 15, l2 >> 4); } }
        if (!side_done && (!has_next || S.side_due(ui))) { S.side(); side_done = true; }
        if (!has_next) break;
#pragma unroll
        for (int a = 0; a < 2; ++a)
#pragma unroll
            for (int b = 0; b < 2; ++b)
#pragma unroll
                for (int m = 0; m < 4; ++m)
#pragma unroll
                    for (int n = 0; n < 2; ++n) acc[a][b][m][n] = (f32x4){0.f, 0.f, 0.f, 0.f};
        cur = nxt; cA = nA; cB = nB; cnt = S.nt(nxt); ++ui;
        if (wr == 1) PG8_BAR;
    }
    PG8_WAIT_V(0);
    PG8_BAR;
    if (MK_MFMA_TWICE) { _Pragma("unroll") for (int q = 0; q < 4; ++q) asm volatile("" :: "v"(dummy_acc[q])); }
#undef PG8_SA
#undef PG8_SB
#undef PG8_STAGE
#undef PG8_STAGE_A0
#undef PG8_STAGE_A1
#undef PG8_LDA
#undef PG8_LDB
#undef PG8_MMA
#undef PG8_CAT8
#undef PG8_WAIT_V
#undef PG8_WAIT_V8
#undef PG8_DMX
#undef PG8_LDX
#undef PG8_WAIT_L
#undef PG8_BAR
#undef PG8_SCHED
}
}
using pg8::Unit;

struct Args { const void* in[26]; float* out; unsigned char* ws; int ph_lo, ph_hi; };
struct Frame {
    LAS unsigned char* lds; int tid, lane, wave, G, bid;
    const float *x, *mem; const int* pos; const float *g1, *w_in, *b_gate, *w_pg, *pool_scale, *w_pp, *gq, *gk, *sink, *w_ap, *gmem, *w_mkv, *gmq, *gmk, *w_mp, *w_out, *g2, *w_r, *b_r, *w_up, *b_up, *w_dn, *b_dn;
    float* out; unsigned char* ws; unsigned* ctl;
    bf16_t *WinT, *WcatT, *WoutT, *WmkvT, *WupT, *WdnT, *xn, *mn, *proj, *kvraw, *qn, *kn, *vT, *mqn, *mk, *mvT, *acat, *merged, *xn2, *act, *ybuf;
    float *wrf, *mscr, *tw; int* list; unsigned* er; unsigned char *xn8, *Win8, *acat8, *Wcat8; bf16_t *wrh, *wrl, *h1b; unsigned char *gate8, *xg;
};

__host__ __device__ __forceinline__ void fill_frame(Frame& F, const void* const* in, float* out, unsigned char* ws) {
    F.x = (const float*)in[0]; F.mem = (const float*)in[1]; F.pos = (const int*)in[2]; F.g1 = (const float*)in[3]; F.w_in = (const float*)in[4]; F.b_gate = (const float*)in[5];
    F.w_pg = (const float*)in[6]; F.pool_scale = (const float*)in[7]; F.w_pp = (const float*)in[8]; F.gq = (const float*)in[9]; F.gk = (const float*)in[10]; F.sink = (const float*)in[11];
    F.w_ap = (const float*)in[12]; F.gmem = (const float*)in[13]; F.w_mkv = (const float*)in[14]; F.gmq = (const float*)in[15]; F.gmk = (const float*)in[16]; F.w_mp = (const float*)in[17];
    F.w_out = (const float*)in[18]; F.g2 = (const float*)in[19]; F.w_r = (const float*)in[20]; F.b_r = (const float*)in[21]; F.w_up = (const float*)in[22]; F.b_up = (const float*)in[23];
    F.w_dn = (const float*)in[24]; F.b_dn = (const float*)in[25];
    F.out = out; F.ws = ws; F.ctl = (unsigned*)(ws + WS_CTL);
    F.WinT = (bf16_t*)(ws + WS_WIN_T); F.WcatT = (bf16_t*)(ws + WS_WCAT_T); F.WoutT = (bf16_t*)(ws + WS_WOUT_T); F.WmkvT = (bf16_t*)(ws + WS_WMKV_T); F.wrf = (float*)(ws + WS_WRF);
    F.WupT = (bf16_t*)(ws + WS_WUP_T); F.WdnT = (bf16_t*)(ws + WS_WDN_T); F.xn = (bf16_t*)(ws + WS_XN); F.mn = (bf16_t*)(ws + WS_MN); F.proj = (bf16_t*)(ws + WS_PROJ); F.kvraw = (bf16_t*)(ws + WS_KVRAW);
    F.qn = (bf16_t*)(ws + WS_QN); F.kn = (bf16_t*)(ws + WS_KN); F.vT = (bf16_t*)(ws + WS_VT); F.mqn = (bf16_t*)(ws + WS_MQN); F.mk = (bf16_t*)(ws + WS_MK); F.mvT = (bf16_t*)(ws + WS_MVT);
    F.acat = (bf16_t*)(ws + WS_ACAT); F.mscr = (float*)(ws + WS_MSCR); F.merged = (bf16_t*)(ws + WS_MERGED); F.xn2 = (bf16_t*)(ws + WS_XN2); F.list = (int*)(ws + WS_LIST); F.er = (unsigned*)(ws + WS_ER);
    F.tw = (float*)(ws + WS_TW); F.act = (bf16_t*)(ws + WS_ACT); F.ybuf = (bf16_t*)(ws + WS_YBUF); F.xn8 = ws + WS_XN8; F.Win8 = ws + WS_WIN8; F.acat8 = ws + WS_ACAT8; F.Wcat8 = ws + WS_WCAT8; F.wrh = (bf16_t*)(ws + WS_WRH); F.wrl = (bf16_t*)(ws + WS_WRL); F.h1b = (bf16_t*)(ws + WS_H1B); F.gate8 = ws + WS_GATE8; F.xg = ws + WS_XG;
}
static Frame host_frame(void* const* d_in, float* out, unsigned char* ws) { Frame F{}; fill_frame(F, (const void* const*)d_in, out, ws); return F; }

__device__ __forceinline__ void tr_load(const float* W, int N, int kb, int nb, int lane, f32x4 (&v)[16]) {
    const float* p = W + (size_t)(64 * kb + 16 * (lane >> 4)) * N + 64 * nb + 4 * (lane & 15);
#pragma unroll
    for (int i = 0; i < 16; ++i) v[i] = __builtin_nontemporal_load((const f32x4*)(p + (size_t)i * N));
}
template <bool FP8>
__device__ __forceinline__ void tr_store(const f32x4 (&v)[16], unsigned char* WT, size_t ldt_bytes, int koff, int kb, int nb, float scale, int lane) {
    const int kq = lane >> 4, nq = lane & 15;
#pragma unroll
    for (int j = 0; j < 4; ++j) {
        unsigned char* row = WT + (size_t)(64 * nb + 4 * nq + j) * ldt_bytes;
        if (FP8) { u32x4 o; unsigned w;
            w = __builtin_amdgcn_cvt_pk_fp8_f32(v[0][j] * scale, v[1][j] * scale, 0u, false); o.x = __builtin_amdgcn_cvt_pk_fp8_f32(v[2][j] * scale, v[3][j] * scale, w, true);
            w = __builtin_amdgcn_cvt_pk_fp8_f32(v[4][j] * scale, v[5][j] * scale, 0u, false); o.y = __builtin_amdgcn_cvt_pk_fp8_f32(v[6][j] * scale, v[7][j] * scale, w, true);
            w = __builtin_amdgcn_cvt_pk_fp8_f32(v[8][j] * scale, v[9][j] * scale, 0u, false); o.z = __builtin_amdgcn_cvt_pk_fp8_f32(v[10][j] * scale, v[11][j] * scale, w, true);
            w = __builtin_amdgcn_cvt_pk_fp8_f32(v[12][j] * scale, v[13][j] * scale, 0u, false); o.w = __builtin_amdgcn_cvt_pk_fp8_f32(v[14][j] * scale, v[15][j] * scale, w, true);
            *(u32x4*)(row + (size_t)(koff + 64 * kb + 16 * kq)) = o;
        } else { u32x4 o0, o1;
            o0.x = pk2(v[0][j], v[1][j]); o0.y = pk2(v[2][j], v[3][j]); o0.z = pk2(v[4][j], v[5][j]); o0.w = pk2(v[6][j], v[7][j]);
            o1.x = pk2(v[8][j], v[9][j]); o1.y = pk2(v[10][j], v[11][j]); o1.z = pk2(v[12][j], v[13][j]); o1.w = pk2(v[14][j], v[15][j]);
            u32x4* dst = (u32x4*)(row + (size_t)(koff + 64 * kb + 16 * kq) * 2); dst[0] = o0; dst[1] = o1; }
    }
}
__device__ __forceinline__ void p0_transpose_item(const float* W, int N, int K, bf16_t* WT, int ldt, int koff, int item, int lane) {
    const int nkb = K / 64, kb = item % nkb, nb = item / nkb; f32x4 v[16];
    tr_load(W, N, kb, nb, lane, v); tr_store<false>(v, (unsigned char*)WT, (size_t)ldt * 2, koff, kb, nb, 1.0f, lane);
}
struct MoeItem { const float* W; unsigned char* WT; int N; };
constexpr int MOE_ITEMS = NE * (16 * 128 + 16 * 64);
__device__ __forceinline__ MoeItem moe_item(const Frame& F, int it, const bool alt = false) {
    constexpr int I_UP1 = 16 * 128, I_UP = NE * I_UP1, I_DN1 = 16 * 64; MoeItem m;
    if (it < I_UP) { const int e = it / I_UP1, r = it % I_UP1, kb = r >> 7, nb = r & 127; m.N = 2 * DFF;
        m.W = alt ? F.w_up + ((size_t)e * D + 16 * (r >> 4)) * (2 * DFF) + 256 * (r & 15) : F.w_up + ((size_t)e * D + 128 * kb) * (2 * DFF) + 32 * nb; m.WT = MOE_W_KTILE_MAJOR ? (unsigned char*)F.WupT + (size_t)e * 2 * DFF * D + ((size_t)kb * 2 * DFF + 32 * nb) * 128 : (unsigned char*)F.WupT + (((size_t)e * 2 * DFF + 32 * nb) * D + 128 * kb) * MOE_EB; }
    else { const int i2 = it - I_UP, e = i2 / I_DN1, r = i2 % I_DN1, kb = r >> 6, nb = r & 63; m.N = D;
        m.W = alt ? F.w_dn + ((size_t)e * DFF + 16 * (r >> 3)) * D + 256 * (r & 7) : F.w_dn + ((size_t)e * DFF + 128 * kb) * D + 32 * nb; m.WT = MOE_W_KTILE_MAJOR ? (unsigned char*)F.WdnT + (size_t)e * D * DFF + ((size_t)kb * D + 32 * nb) * 128 : (unsigned char*)F.WdnT + (((size_t)e * D + 32 * nb) * DFF + 128 * kb) * MOE_EB; }
    return m;
}
__device__ __forceinline__ void moe_load(const MoeItem& m, int lane, f32x4 (&v)[16], const bool alt = false) {
    const float* p = alt ? m.W + 4 * lane : m.W + (size_t)(16 * (lane & 7)) * m.N + 4 * (lane >> 3);
#pragma unroll
    for (int i = 0; i < 16; ++i) v[i] = __builtin_nontemporal_load((const f32x4*)(p + (size_t)i * m.N));
}
__device__ __forceinline__ void moe_store(const MoeItem& m, int lane, const f32x4 (&v)[16]) {
#pragma unroll
    for (int j = 0; j < 4; ++j) {
        unsigned char* dst = m.WT + ((size_t)(4 * (lane >> 3) + j) * (MOE_W_KTILE_MAJOR ? 128 : 2048) + 16 * (lane & 7)) * MOE_EB;
        if (MOE_FP8) { u32x4 o; unsigned w;
            w = __builtin_amdgcn_cvt_pk_fp8_f32(v[0][j] * MOE_WSCALE, v[1][j] * MOE_WSCALE, 0u, false); o.x = __builtin_amdgcn_cvt_pk_fp8_f32(v[2][j] * MOE_WSCALE, v[3][j] * MOE_WSCALE, w, true);
            w = __builtin_amdgcn_cvt_pk_fp8_f32(v[4][j] * MOE_WSCALE, v[5][j] * MOE_WSCALE, 0u, false); o.y = __builtin_amdgcn_cvt_pk_fp8_f32(v[6][j] * MOE_WSCALE, v[7][j] * MOE_WSCALE, w, true);
            w = __builtin_amdgcn_cvt_pk_fp8_f32(v[8][j] * MOE_WSCALE, v[9][j] * MOE_WSCALE, 0u, false); o.z = __builtin_amdgcn_cvt_pk_fp8_f32(v[10][j] * MOE_WSCALE, v[11][j] * MOE_WSCALE, w, true);
            w = __builtin_amdgcn_cvt_pk_fp8_f32(v[12][j] * MOE_WSCALE, v[13][j] * MOE_WSCALE, 0u, false); o.w = __builtin_amdgcn_cvt_pk_fp8_f32(v[14][j] * MOE_WSCALE, v[15][j] * MOE_WSCALE, w, true);
            __builtin_nontemporal_store(o, (u32x4*)dst);
        } else { u32x4 o0, o1;
            o0.x = pk2(v[0][j], v[1][j]); o0.y = pk2(v[2][j], v[3][j]); o0.z = pk2(v[4][j], v[5][j]); o0.w = pk2(v[6][j], v[7][j]);
            o1.x = pk2(v[8][j], v[9][j]); o1.y = pk2(v[10][j], v[11][j]); o1.z = pk2(v[12][j], v[13][j]); o1.w = pk2(v[14][j], v[15][j]);
            ((u32x4*)dst)[0] = o0; ((u32x4*)dst)[1] = o1; }
    }
}
__device__ __forceinline__ void moe_convert(const Frame& F, int wk, int nwk, int lane, const int mode = 0, const int lo = 0, const int MOE_HI = MOE_ITEMS) {
    int it = lo + wk; if (it >= MOE_HI) return;
    f32x4 va[16], vb[16], vc[16];
    if (mode == 2) { _Pragma("unroll") for (int q = 0; q < 16; ++q) { va[q] = (f32x4){1.f, 2.f, 3.f, 4.f}; vb[q] = va[q]; vc[q] = va[q]; } }
    MoeItem ma = moe_item(F, it, mode == 3), mb = ma, mc = ma;
    if (mode != 2) moe_load(ma, lane, va, mode == 3);
    if (it + nwk < MOE_HI) { mb = moe_item(F, it + nwk, mode == 3); if (mode != 2) moe_load(mb, lane, vb, mode == 3); }
#define MOE_STEP(MS, VS, ML, VL) { const bool more2 = it + 2 * nwk < MOE_HI; if (more2) { ML = moe_item(F, it + 2 * nwk, mode == 3); if (mode != 2) moe_load(ML, lane, VL, mode == 3); } \
        if (mode == 1 || mode == 3) { _Pragma("unroll") for (int q = 0; q < 16; ++q) asm volatile("" :: "v"(VS[q])); } \
        else { if (mode == 2) MS.WT = (unsigned char*)F.act + (MS.WT - (unsigned char*)F.WupT); moe_store(MS, lane, VS); } \
        it += nwk; if (it >= MOE_HI) break; }
    for (;;) {
        MOE_STEP(ma, va, mc, vc)
        MOE_STEP(mb, vb, ma, va)
        MOE_STEP(mc, vc, mb, vb)
    }
#undef MOE_STEP
}
__device__ __forceinline__ void p0_fold_item(const Frame& F, LAS float* scr, int item, int lane) {
    const int kb = item >> 6, nb = item & 63, k0 = 16 * kb, g = k0 >> 7, c0 = k0 & 127, n0 = 32 * nb, nn = lane & 31, kh = lane >> 5;
    float acc[8];
#pragma unroll
    for (int i = 0; i < 8; ++i) acc[i] = 0.f;
    const float* wg = F.w_pg + (size_t)(g * 128 + c0 + kh) * 128;
#pragma unroll 4
    for (int d = 0; d < 128; ++d) {
        const float wp = F.w_pp[(size_t)(g * 128 + d) * D + n0 + nn] * F.pool_scale[g * 128 + d];
#pragma unroll
        for (int i = 0; i < 8; ++i) acc[i] += wg[(size_t)(2 * i) * 128 + d] * wp;
    }
#pragma unroll
    for (int i = 0; i < 8; ++i) scr[(2 * i + kh) * 33 + nn] = acc[i];
    LDS_WAIT();
    { const int n = lane >> 1, hf = lane & 1; const LAS float* s = scr + (8 * hf) * 33 + n;
      u32x4 o; o.x = pk2(s[0 * 33], s[1 * 33]); o.y = pk2(s[2 * 33], s[3 * 33]); o.z = pk2(s[4 * 33], s[5 * 33]); o.w = pk2(s[6 * 33], s[7 * 33]);
      *(u32x4*)(F.WcatT + (size_t)(n0 + n) * D + k0 + 8 * hf) = o; }
    LDS_WAIT();
}
__device__ __forceinline__ void rms_row_to_bf16(const float* xrow, const float* gain, bf16_t* orow, int lane, unsigned char* orow8 = nullptr) {
    const f32x4* xr = (const f32x4*)xrow + lane; const f32x4* gr = (const f32x4*)gain + lane;
    f32x4 v[8]; float s = 0.f;
#pragma unroll
    for (int j = 0; j < 8; ++j) { v[j] = xr[64 * j]; s += (v[j].x * v[j].x + v[j].y * v[j].y) + (v[j].z * v[j].z + v[j].w * v[j].w); }
    const float r = __builtin_amdgcn_rsqf(wave_sum(s) * (1.f / D) + NORM_EPS);
    u32x2* o8 = (u32x2*)orow + lane;
#pragma unroll
    for (int j = 0; j < 8; ++j) { const f32x4 g = gr[64 * j]; const f32x4 y = {v[j].x * r * g.x, v[j].y * r * g.y, v[j].z * r * g.z, v[j].w * r * g.w};
        u32x2 o; o.x = pk2(y.x, y.y); o.y = pk2(y.z, y.w); o8[64 * j] = o;
        if (orow8) { const unsigned t = __builtin_amdgcn_cvt_pk_fp8_f32(y.x, y.y, 0u, false); ((unsigned*)orow8)[lane + 64 * j] = __builtin_amdgcn_cvt_pk_fp8_f32(y.z, y.w, t, true); } }
}
__device__ __forceinline__ void p0_prep(const Frame& F) {
    LAS float* scr = (LAS float*)(F.lds + F.wave * 16384);
    const int gw = F.bid * 8 + F.wave, NGW = F.G * 8, lane = F.lane;
    constexpr int I_FOLD = 2048, I_IN = 32 * (P1_NBF * 4), I_IN8 = 32 * (P1_NF8 * 4), I_MKV = 32 * 16, I_AP = 16 * 32, I_MP = 8 * 32, I_OUT = 32 * 32;
    constexpr int I_XN = NTOK, I_MN = NMEMROW, I_WRF = 32;
    constexpr int NITEMS = I_FOLD + I_IN + I_IN8 + I_MKV + I_AP + I_MP + I_OUT + I_XN + I_MN + I_WRF;
    const int nmine = (NITEMS - gw + NGW - 1) / NGW;
    for (int it = gw, jj = 0; it < NITEMS; it += NGW, ++jj) {
        int r = (F.bid & 1) ? gw + (nmine - 1 - jj) * NGW : it;
        if (r < I_FOLD) { p0_fold_item(F, scr, r, lane); continue; } r -= I_FOLD;
        if (r < I_XN) { rms_row_to_bf16(F.x + (size_t)r * D, F.g1, F.xn + (size_t)r * D, lane, P1_FP8_TILES ? F.xn8 + (size_t)r * D : nullptr); continue; } r -= I_XN;
        if (r < I_MN) { rms_row_to_bf16(F.mem + (size_t)r * D, F.gmem, F.mn + (size_t)r * D, lane); continue; } r -= I_MN;
        if (r < I_IN) { const int kb = r & 31, q = r >> 5, nb = p1_tile_bf(q >> 2) * 4 + (q & 3); f32x4 v[16];
            tr_load(F.w_in, IN_W, kb, nb, lane, v); tr_store<false>(v, (unsigned char*)F.WinT, (size_t)D * 2, 0, kb, nb, 1.0f, lane); continue; } r -= I_IN;
        if (r < I_IN8) { const int kb = r & 31, q = r >> 5, nbs = p1_tile_f8(q >> 2) * 4 + (q & 3); f32x4 v[16];
            tr_load(F.w_in, IN_W, kb, nbs, lane, v); tr_store<true>(v, F.Win8, (size_t)D, 0, kb, q, 64.0f, lane); continue; } r -= I_IN8;
        if (r < I_MKV) { p0_transpose_item(F.w_mkv, 1024, D, F.WmkvT, D, 0, r, lane); continue; } r -= I_MKV;
        if (r < I_AP) { if (P4_FP8) { const int kb = r & 15, nb = r >> 4; f32x4 v[16]; tr_load(F.w_ap, D, kb, nb, lane, v); tr_store<true>(v, F.Wcat8, (size_t)1536, 0, kb, nb, 64.0f, lane); }
                        else p0_transpose_item(F.w_ap, D, 1024, F.WcatT, D, 512, r, lane); continue; } r -= I_AP;
        if (r < I_MP) { if (P4_FP8) { const int kb = r & 7, nb = r >> 3; f32x4 v[16]; tr_load(F.w_mp, D, kb, nb, lane, v); tr_store<true>(v, F.Wcat8, (size_t)1536, 1024, kb, nb, 64.0f, lane); }
                        else p0_transpose_item(F.w_mp, D, 512, F.WcatT, D, 1536, r, lane); continue; } r -= I_MP;
        if (r < I_OUT) { p0_transpose_item(F.w_out, D, D, F.WoutT, D, 0, r, lane); continue; } r -= I_OUT;
        { for (int i = r * 2048 + lane; i < (r + 1) * 2048; i += 64) { const float v = F.w_r[i] * F.g2[i >> 5]; const bf16_t hi = f2bf(v); F.wrf[i] = v; F.wrh[(size_t)(i & 31) * D + (i >> 5)] = hi; F.wrl[(size_t)(i & 31) * D + (i >> 5)] = f2bf(v - bf2f(hi)); } }
    }
#if !MOE_CONV_IN_P1 || MOE_PROBE
    moe_convert(F, gw, NGW, lane);
#endif
}

constexpr int MOE_EXTRA = 10;
#ifndef MOE_SIDE_B_AFTER
#define MOE_SIDE_B_AFTER 5
#endif
__device__ __forceinline__ void moe_side(const Frame& F, int G, int c) {
    const int wave = (int)__builtin_amdgcn_readfirstlane(threadIdx.x >> 6), lane = threadIdx.x & 63;
    const int rem = (64 * P1_NBF + 16) % G, nlight = rem ? G - rem : 0, m1 = MOE_ITEMS - nlight * 8 * MOE_EXTRA;
    moe_convert(F, c * 8 + wave, G * 8, lane, MOE_PROBE, 0, m1);
    if (rem && c >= rem) moe_convert(F, (c - rem) * 8 + wave, nlight * 8, lane, MOE_PROBE, m1, MOE_ITEMS);
    asm volatile("s_waitcnt vmcnt(0)" ::: "memory");
}

struct SchedP1 {
    __device__ __forceinline__ size_t kstep_a() const { return 128; }
    __device__ __forceinline__ size_t kstep_b() const { return 128; }
    const Frame* F;
#if MOE_CONV_IN_P1
    __device__ __forceinline__ bool side_due(int ui) const { return c * 2 < G; }
    __device__ __forceinline__ void side() const { if (c * 2 < G) moe_side(*F, G, c); }
#else
    __device__ __forceinline__ bool side_due(int) const { return false; } __device__ __forceinline__ void side() const {}
#endif
    static constexpr bool GATHER = false, FP8 = false; static constexpr int SCALE_B = 0x7f7f7f7f;
    int lda, ldb, G, c; const char *xn, *mn, *WinT, *WmkvT;
    __device__ __forceinline__ bool next(int i, Unit& u) const {
        const int L = i * G + c; constexpr int NT = P1_NBF, N1 = 64 * NT;
        if (L < N1) { int b; pg8::tile_of(L, 64, NT, u.pm, b); u.pn = p1_tile_bf(b); u.aux = 0; return true; }
        if (L < N1 + 16) { const int j = L - N1; u.pm = j >> 2; u.pn = j & 3; u.aux = 1; return true; }
        return false;
    }
    __device__ __forceinline__ const char* a_base(const Unit& u) const { return (u.aux ? mn : xn) + (size_t)u.pm * 256 * D * 2; }
    __device__ __forceinline__ const char* b_base(const Unit& u) const { return (u.aux ? WmkvT : WinT) + (size_t)u.pn * 256 * D * 2; }
    __device__ __forceinline__ int nt(const Unit&) const { return D / 64; }
    __device__ __forceinline__ unsigned gather(const Unit&, int, int) const { return 0u; }
};
struct SchedP1b {
    __device__ __forceinline__ size_t kstep_a() const { return 128; }
    __device__ __forceinline__ size_t kstep_b() const { return 128; }
    const Frame* F;
#if MOE_CONV_IN_P1
    __device__ __forceinline__ bool side_due(int ui) const { return c * 2 >= G && ui >= MOE_SIDE_B_AFTER; }
    __device__ __forceinline__ void side() const { if (c * 2 >= G) moe_side(*F, G, c); }
#else
    __device__ __forceinline__ bool side_due(int) const { return false; } __device__ __forceinline__ void side() const {}
#endif
    static constexpr bool GATHER = false, FP8 = true; static constexpr int SCALE_B = 0x79797979;
    int lda, ldb, G, c; const char *xn8, *Win8;
    __device__ __forceinline__ bool next(int i, Unit& u) const {
        const int L = i * G + c; if (L >= 64 * P1_NF8) return false;
        int f; pg8::tile_of(L, 64, P1_NF8 ? P1_NF8 : 1, u.pm, f); u.pn = p1_tile_f8(f); u.aux = 0; return true;
    }
    __device__ __forceinline__ const char* a_base(const Unit& u) const { return xn8 + (size_t)u.pm * 256 * D; }
    __device__ __forceinline__ const char* b_base(const Unit& u) const { return Win8 + (size_t)p1_f8_index(u.pn) * 256 * D; }
    __device__ __forceinline__ int nt(const Unit&) const { return D / 128; }
    __device__ __forceinline__ unsigned gather(const Unit&, int, int) const { return 0u; }
};
struct EpiP1 {
    static constexpr bool PROBE_TWICE = (MK_EPI_TWICE == 1);
    static constexpr int MODE = 1;
    bf16_t* proj; bf16_t* kvraw; const float* b_gate; unsigned char* gate8;
    __device__ __forceinline__ void operator()(const f32x4 (&acc)[2][2][4][2], const Unit& u, int wr, int wc, int fr, int fq) const {
        const int row0 = u.pm * 256 + wr * 64 + fr, cw = u.pn * 256 + wc * 64 + fq * 16;
        bf16_t* base; int ldc; const bool gate = (u.aux == 0) && (u.pn >= OFF_GATE / 256), g8 = GATE_BC_FP8 && (u.aux == 0) && (u.pn >= 18);
        if (u.aux == 0) { base = proj + cw; ldc = IN_W; } else { base = kvraw + cw; ldc = 1024; }
        f32x4 bv[2][2];
#pragma unroll
        for (int bj = 0; bj < 2; ++bj)
#pragma unroll
            for (int n = 0; n < 2; ++n) bv[bj][n] = gate ? *(const f32x4*)(b_gate + (cw - OFF_GATE) + bj * 8 + n * 4) : (f32x4){0.f, 0.f, 0.f, 0.f};
#pragma unroll
        for (int ai = 0; ai < 2; ++ai)
#pragma unroll
            for (int m = 0; m < 4; ++m) { bf16_t* rowp = base + (size_t)(row0 + ai * 128 + m * 16) * ldc; u32x4 w8;
#pragma unroll
                for (int bj = 0; bj < 2; ++bj) { f32x4 v0 = acc[ai][bj][m][0] + bv[bj][0], v1 = acc[ai][bj][m][1] + bv[bj][1];
                    if (gate) {
#pragma unroll
                        for (int j = 0; j < 4; ++j) { v0[j] = fast_sigmoid(v0[j]); v1[j] = fast_sigmoid(v1[j]); } }
                    if (g8) { unsigned t = __builtin_amdgcn_cvt_pk_fp8_f32(v0[0], v0[1], 0u, false); const unsigned a = __builtin_amdgcn_cvt_pk_fp8_f32(v0[2], v0[3], t, true);
                        t = __builtin_amdgcn_cvt_pk_fp8_f32(v1[0], v1[1], 0u, false); const unsigned b = __builtin_amdgcn_cvt_pk_fp8_f32(v1[2], v1[3], t, true);
                        if (bj == 0) { w8.x = a; w8.y = b; } else { w8.z = a; w8.w = b; } }
                    else { u32x4 w; w.x = pk2(v0[0], v0[1]); w.y = pk2(v0[2], v0[3]); w.z = pk2(v1[0], v1[1]); w.w = pk2(v1[2], v1[3]);
                        *(u32x4*)(rowp + bj * 8) = w; } }
                if (g8) *(u32x4*)(gate8 + (size_t)(row0 + ai * 128 + m * 16) * (2 * D) + (cw - 18 * 256)) = w8; }
    }
};

__device__ __forceinline__ float row16_sum(float v) {
    v += __builtin_bit_cast(float, __builtin_amdgcn_update_dpp(0, __builtin_bit_cast(int, v), 0xB1, 0xf, 0xf, true));
    v += __builtin_bit_cast(float, __builtin_amdgcn_update_dpp(0, __builtin_bit_cast(int, v), 0x4E, 0xf, 0xf, true));
    v += __builtin_bit_cast(float, __builtin_amdgcn_update_dpp(0, __builtin_bit_cast(int, v), 0x141, 0xf, 0xf, true));
    v += __builtin_bit_cast(float, __builtin_amdgcn_update_dpp(0, __builtin_bit_cast(int, v), 0x140, 0xf, 0xf, true));
    return v;
}
__device__ __forceinline__ float row_ror8(float v) { return __builtin_bit_cast(float, __builtin_amdgcn_update_dpp(0, __builtin_bit_cast(int, v), 0x128, 0xf, 0xf, true)); }
__device__ __forceinline__ void p2_token(const Frame& F, int t, int lane) {
    const int s = t % SEQ; const int b = t / SEQ;
    const bf16_t* prow = F.proj + (size_t)t * IN_W;
    const int row = lane >> 4, j = lane & 15, jf = j & 7;
    const float posf = (float)F.pos[t];
    float cs[8], sn[8];
#pragma unroll
    for (int e = 0; e < 8; ++e) {
        const float inv_freq = __builtin_amdgcn_exp2f(-(float)(8 * jf + e) * (13.287712379549449f / 64.0f)), ang = posf * inv_freq, kq = __builtin_rintf(ang * 0.15915494309189535f);
        float rr = __builtin_fmaf(-kq, 6.2831854820251465f, ang); rr = __builtin_fmaf(-kq, -1.7484556000744883e-07f, rr);
        cs[e] = __cosf(rr); sn[e] = j < 8 ? -__sinf(rr) : __sinf(rr); }
#pragma unroll
    for (int pass = 0; pass < 4; ++pass) {
        const int hidx = 4 * pass + row; const bool active = hidx < 14, isq = hidx < 8, isk = hidx >= 8 && hidx < 10;
        const int hh = isq ? hidx : (isk ? hidx - 8 : (active ? hidx - 10 : 0));
        const bf16_t* src = prow + (isq ? OFF_Q : (isk ? OFF_K : OFF_MQ)) + hh * 128 + 8 * j;
        const float* gp = (isq ? F.gq : (isk ? F.gk : F.gmq)) + 8 * j;
        bf16_t* dst = (isq ? F.qn + (size_t)t * 1024 : (isk ? F.kn + (size_t)t * 256 : F.mqn + (size_t)t * 512)) + hh * 128 + 8 * j;
        const u32x4 raw = *(const u32x4*)src; const f32x4 g0 = *(const f32x4*)gp, g1 = *(const f32x4*)(gp + 4);
        float v[8] = {bflo(raw.x), bfhi(raw.x), bflo(raw.y), bfhi(raw.y), bflo(raw.z), bfhi(raw.z), bflo(raw.w), bfhi(raw.w)};
        float ss = 0.f;
#pragma unroll
        for (int e = 0; e < 8; ++e) ss += v[e] * v[e];
        const float r = __builtin_amdgcn_rsqf(row16_sum(ss) * (1.f / 128.f) + NORM_EPS), sc = isk ? 1.0f : QSCALE; const bool rot = isq || isk;
        const float g[8] = {g0.x, g0.y, g0.z, g0.w, g1.x, g1.y, g1.z, g1.w}; float y[8];
#pragma unroll
        for (int e = 0; e < 8; ++e) { const float a = v[e] * r * g[e], pr = row_ror8(a); y[e] = (rot ? a * cs[e] + pr * sn[e] : a) * sc; }
        u32x4 o; o.x = pk2(y[0], y[1]); o.y = pk2(y[2], y[3]); o.z = pk2(y[4], y[5]); o.w = pk2(y[6], y[7]);
        if (active) *(u32x4*)dst = o;
    }
    {
        const int g = lane >> 4, w = 2 << g; int lo = s - (w >> 1), hi = lo + w; lo = lo < 0 ? 0 : lo; hi = hi > SEQ ? SEQ : hi;
        float a[8];
#pragma unroll
        for (int j = 0; j < 8; ++j) a[j] = 0.f;
        const bf16_t* up = F.proj + (size_t)(b * SEQ) * IN_W + OFF_POOL + lane * 8;
        u32x4 wv[16];
#pragma unroll
        for (int jj = 0; jj < 16; ++jj) { const int rj = s - 8 + jj; wv[jj] = (rj >= lo && rj < hi) ? *(const u32x4*)(up + (size_t)rj * IN_W) : (u32x4){0u, 0u, 0u, 0u}; }
#pragma unroll
        for (int jj = 0; jj < 16; ++jj) { const u32x4 v = wv[jj];
            a[0] += bflo(v.x); a[1] += bfhi(v.x); a[2] += bflo(v.y); a[3] += bfhi(v.y); a[4] += bflo(v.z); a[5] += bfhi(v.z); a[6] += bflo(v.w); a[7] += bfhi(v.w); }
        const u32x4 me = *(const u32x4*)(up + (size_t)s * IN_W); const float ic = 1.0f / (float)(hi - lo);
        u32x4 o; o.x = pk2(a[0] * ic - bflo(me.x), a[1] * ic - bfhi(me.x)); o.y = pk2(a[2] * ic - bflo(me.y), a[3] * ic - bfhi(me.y));
        o.z = pk2(a[4] * ic - bflo(me.z), a[5] * ic - bfhi(me.z)); o.w = pk2(a[6] * ic - bflo(me.w), a[7] * ic - bfhi(me.w));
        *(u32x4*)(F.acat + (size_t)t * D + lane * 8) = o;
    }
}
__device__ __forceinline__ void p2_transpose64(const bf16_t* src, int src_ld, bf16_t* dst, int dst_ld, LAS bf16_t* scr, int lane) {
    const bf16_t* sp = src + (size_t)lane * src_ld;
#pragma unroll
    for (int i = 0; i < 8; ++i) { const u32x4 v = *(const u32x4*)(sp + 8 * i);
        scr[(8 * i + 0) * 66 + lane] = (bf16_t)(v.x & 0xffff); scr[(8 * i + 1) * 66 + lane] = (bf16_t)(v.x >> 16); scr[(8 * i + 2) * 66 + lane] = (bf16_t)(v.y & 0xffff); scr[(8 * i + 3) * 66 + lane] = (bf16_t)(v.y >> 16);
        scr[(8 * i + 4) * 66 + lane] = (bf16_t)(v.z & 0xffff); scr[(8 * i + 5) * 66 + lane] = (bf16_t)(v.z >> 16); scr[(8 * i + 6) * 66 + lane] = (bf16_t)(v.w & 0xffff); scr[(8 * i + 7) * 66 + lane] = (bf16_t)(v.w >> 16); }
    LDS_WAIT();
    const LAS unsigned* rp = (const LAS unsigned*)(scr + lane * 66);
    bf16_t* dp = dst + (size_t)lane * dst_ld;
#pragma unroll
    for (int i = 0; i < 8; ++i) { u32x4 o; o.x = rp[4 * i]; o.y = rp[4 * i + 1]; o.z = rp[4 * i + 2]; o.w = rp[4 * i + 3]; *(u32x4*)(dp + 8 * i) = o; }
    LDS_WAIT();
}
__device__ __forceinline__ void p2_prepass(const Frame& F) {
    LAS bf16_t* scr = (LAS bf16_t*)(F.lds + F.wave * 16384);
    const int gw = F.bid * 8 + F.wave, NGW = F.G * 8, lane = F.lane;
    constexpr int J_VT = NBATCH * 2 * 64 * 2, J_MVT = NBATCH * 4 * 4 * 2, J_MK = NMEMROW, J_TOK = NTOK;
    for (int it = gw; it < J_VT + J_MVT + J_MK + J_TOK; it += NGW) {
        int r = it;
        if (r < J_VT) { const int dc = r & 1, tj = (r >> 1) & 63, kvh = (r >> 7) & 1, b = r >> 8;
            p2_transpose64(F.proj + (size_t)(b * SEQ + 64 * tj) * IN_W + OFF_V + kvh * 128 + 64 * dc, IN_W, F.vT + ((size_t)((b * 2 + kvh) * 128 + 64 * dc)) * SEQ + 64 * tj, SEQ, scr, lane); continue; } r -= J_VT;
        if (r < J_MVT) { const int dc = r & 1, tj = (r >> 1) & 3, h = (r >> 3) & 3, b = r >> 5;
            p2_transpose64(F.kvraw + (size_t)(b * MEMLEN + 64 * tj) * 1024 + 512 + h * 128 + 64 * dc, 1024, F.mvT + ((size_t)((b * 4 + h) * 128 + 64 * dc)) * MEMLEN + 64 * tj, MEMLEN, scr, lane); continue; } r -= J_MVT;
        if (r < J_MK) { const float g1 = F.gmk[lane], g2 = F.gmk[64 + lane];
#pragma unroll
            for (int hd = 0; hd < 4; ++hd) { const float x1 = bf2f(F.kvraw[(size_t)r * 1024 + hd * 128 + lane]), x2 = bf2f(F.kvraw[(size_t)r * 1024 + hd * 128 + 64 + lane]);
                const float q = __builtin_amdgcn_rsqf(wave_sum(x1 * x1 + x2 * x2) * (1.f / 128.f) + NORM_EPS);
                F.mk[(size_t)r * 512 + hd * 128 + lane] = f2bf(x1 * q * g1); F.mk[(size_t)r * 512 + hd * 128 + 64 + lane] = f2bf(x2 * q * g2); }
            continue; } r -= J_MK;
        p2_token(F, r, lane);
    }
}

constexpr int AT_KROW = 272, AT_VROW = 144, AT_KBYTES = 64 * AT_KROW, AT_VBYTES = 128 * AT_VROW, AT_BUF = AT_KBYTES + AT_VBYTES;
template <bool LOCAL>
__device__ __forceinline__ void attn_unit(const Frame& F, const bf16_t* qrow, const bf16_t* kbase, int k_ld, const bf16_t* vtbase, int vt_ld,
                                          int kt_lo, int ntile, int qi, float m0, float l0, bf16_t* orow, unsigned char* orow8) {
    LAS unsigned char* lds = F.lds; const int tid = F.tid, lane = F.lane, r = lane & 31, h = lane >> 5;
    const int kr = (r & 0x13) | ((r & 4) << 1) | ((r & 8) >> 1);
    bf16x8 qf[8];
#pragma unroll
    for (int st = 0; st < 8; ++st) qf[st] = *(const bf16x8*)(qrow + 16 * st + 8 * h);
    f32x16 oacc[4];
#pragma unroll
    for (int md = 0; md < 4; ++md)
#pragma unroll
        for (int i = 0; i < 16; ++i) oacc[md][i] = 0.f;
    float mrun = m0, lrun = l0;
    const int kp_row0 = tid >> 4, kp_c = tid & 15, vp_row0 = tid >> 3, vp_c = tid & 7;
    u32x4 kreg[2], vreg[2];
#define AT_LOAD(ks) do { _Pragma("unroll") for (int i = 0; i < 2; ++i) { \
        kreg[i] = *(const u32x4*)(kbase + (size_t)((ks) + kp_row0 + 32 * i) * k_ld + kp_c * 8); \
        vreg[i] = *(const u32x4*)(vtbase + (size_t)(vp_row0 + 64 * i) * vt_ld + (ks) + vp_c * 8); } } while (0)
#define AT_WRITE(buf) do { _Pragma("unroll") for (int i = 0; i < 2; ++i) { \
        *(LAS u32x4*)(lds + (buf) * AT_BUF + (kp_row0 + 32 * i) * AT_KROW + kp_c * 16) = kreg[i]; \
        *(LAS u32x4*)(lds + (buf) * AT_BUF + AT_KBYTES + (vp_row0 + 64 * i) * AT_VROW + vp_c * 16) = vreg[i]; } } while (0)
    AT_LOAD(kt_lo); AT_WRITE(0);
    __syncthreads();
#pragma unroll 1
    for (int j = 0; j < ntile; ++j) {
        const int ks = kt_lo + 64 * j; const bool more = (j + 1 < ntile);
        if (more) AT_LOAD(ks + 64);
        LAS unsigned char* kb = lds + (j & 1) * AT_BUF; LAS unsigned char* vb = kb + AT_KBYTES;
        f32x16 sacc[2];
#pragma unroll
        for (int mt = 0; mt < 2; ++mt) {
#pragma unroll
            for (int i = 0; i < 16; ++i) sacc[mt][i] = 0.f;
#pragma unroll
            for (int st = 0; st < 8; ++st) { const bf16x8 kf = *(const LAS bf16x8*)(kb + (32 * mt + kr) * AT_KROW + (16 * st + 8 * h) * 2);
                sacc[mt] = __builtin_amdgcn_mfma_f32_32x32x16_bf16(kf, qf[st], sacc[mt], 0, 0, 0); }
            __builtin_amdgcn_sched_barrier(0);
        }
        float mx = -1e30f;
        const int q0w = __builtin_amdgcn_readfirstlane(qi - r);
        if (LOCAL && (ks - (q0w + 31) < -128 || ks + 63 - q0w > 128)) { const int dk = ks + 8 * h - qi;
#pragma unroll
            for (int mt = 0; mt < 2; ++mt)
#pragma unroll
                for (int i = 0; i < 16; ++i) { const int d = dk + 32 * mt + (i & 3) + 4 * ((i >> 2) & 1) + 16 * (i >> 3);
                    const float v = (d >= -128 && d <= 128) ? sacc[mt][i] : -1e30f; sacc[mt][i] = v; mx = fmaxf(mx, v); }
        } else {
#pragma unroll
            for (int mt = 0; mt < 2; ++mt)
#pragma unroll
                for (int i = 0; i < 16; ++i) mx = fmaxf(mx, sacc[mt][i]);
        }
        mx = fmaxf(mx, __shfl_xor(mx, 32));
        const float mnew = fmaxf(mrun, mx), alpha = __builtin_amdgcn_exp2f(mrun - mnew);
        mrun = mnew;
        float ls = 0.f;
#pragma unroll
        for (int mt = 0; mt < 2; ++mt)
#pragma unroll
            for (int i = 0; i < 16; ++i) { const float p = __builtin_amdgcn_exp2f(sacc[mt][i] - mnew); sacc[mt][i] = p; ls += p; }
        lrun = lrun * alpha + ls;
#pragma unroll
        for (int md = 0; md < 4; ++md)
#pragma unroll
            for (int i = 0; i < 16; ++i) oacc[md][i] *= alpha;
        bf16x8 pf[2][2];
#pragma unroll
        for (int mt = 0; mt < 2; ++mt)
#pragma unroll
            for (int s2 = 0; s2 < 2; ++s2) { u32x4 p; p.x = pk2(sacc[mt][8 * s2 + 0], sacc[mt][8 * s2 + 1]); p.y = pk2(sacc[mt][8 * s2 + 2], sacc[mt][8 * s2 + 3]);
                p.z = pk2(sacc[mt][8 * s2 + 4], sacc[mt][8 * s2 + 5]); p.w = pk2(sacc[mt][8 * s2 + 6], sacc[mt][8 * s2 + 7]); pf[mt][s2] = __builtin_bit_cast(bf16x8, p); }
#pragma unroll
        for (int md = 0; md < 4; ++md)
#pragma unroll
            for (int mt = 0; mt < 2; ++mt)
#pragma unroll
                for (int s2 = 0; s2 < 2; ++s2) { const bf16x8 vf = *(const LAS bf16x8*)(vb + (32 * md + r) * AT_VROW + (32 * mt + 16 * s2 + 8 * h) * 2);
                    oacc[md] = __builtin_amdgcn_mfma_f32_32x32x16_bf16(vf, pf[mt][s2], oacc[md], 0, 0, 0); if (mt == 1 && s2 == 1) __builtin_amdgcn_sched_barrier(0); }
        if (more) AT_WRITE((j + 1) & 1);
        __syncthreads();
    }
#undef AT_LOAD
#undef AT_WRITE
    const float ltot = lrun + __shfl_xor(lrun, 32), inv = 1.0f / ltot;
#pragma unroll
    for (int md = 0; md < 4; ++md)
#pragma unroll
        for (int g4 = 0; g4 < 4; ++g4) { u32x2 o; o.x = pk2(oacc[md][4 * g4] * inv, oacc[md][4 * g4 + 1] * inv); o.y = pk2(oacc[md][4 * g4 + 2] * inv, oacc[md][4 * g4 + 3] * inv);
            if (P4_FP8) { const unsigned t = __builtin_amdgcn_cvt_pk_fp8_f32(oacc[md][4 * g4] * inv, oacc[md][4 * g4 + 1] * inv, 0u, false);
                *(unsigned*)(orow8 + 32 * md + 8 * g4 + 4 * h) = __builtin_amdgcn_cvt_pk_fp8_f32(oacc[md][4 * g4 + 2] * inv, oacc[md][4 * g4 + 3] * inv, t, true); }
            else *(u32x2*)(orow + 32 * md + 8 * g4 + 4 * h) = o; }
}
__device__ __forceinline__ void p3_attention(const Frame& F) {
    const int w = F.wave, r = F.lane & 31, h = F.lane >> 5;
    const bool xmap = (F.G == 256);
    for (int uu = F.bid, jr = 0; uu < 512 + 256; uu += F.G, ++jr) {
        const int u = !xmap ? uu : (jr < 2 ? 64 * (F.bid & 7) + 32 * jr + (F.bid >> 3) : 512 + 32 * (F.bid & 7) + (F.bid >> 3));
        if (u < 512) {
            const int b = u >> 7, kvh = (u >> 6) & 1, qt = u & 63, g = w >> 1, sub = w & 1, head = kvh * 4 + g;
            const int Q0 = qt * 64, qi = Q0 + sub * 32 + r, t = b * SEQ + qi;
            int lo = Q0 - 128; lo = lo < 0 ? 0 : lo; int hi = Q0 + 192; hi = hi > SEQ ? SEQ : hi;
            attn_unit<true>(F, F.qn + (size_t)t * 1024 + head * 128, F.kn + (size_t)(b * SEQ) * 256 + kvh * 128, 256, F.vT + (size_t)((b * 2 + kvh) * 128) * SEQ, SEQ,
                            lo, (hi - lo) >> 6, qi, F.sink[head] * LOG2E, h == 0 ? 1.0f : 0.0f, F.acat + (size_t)t * D + 512 + head * 128, F.acat8 + (size_t)t * 1536 + head * 128);
        } else {
            const int v = u - 512, b = v >> 6, hm = (v >> 4) & 3, qb = v & 15, qi = qb * 256 + w * 32 + r, t = b * SEQ + qi;
            attn_unit<false>(F, F.mqn + (size_t)t * 512 + hm * 128, F.mk + (size_t)(b * MEMLEN) * 512 + hm * 128, 512, F.mvT + (size_t)((b * 4 + hm) * 128) * MEMLEN, MEMLEN,
                             0, 4, qi, -1e30f, 0.0f, F.acat + (size_t)t * D + 1536 + hm * 128, F.acat8 + (size_t)t * 1536 + 1024 + hm * 128);
        }
    }
}

struct SchedP4 {
    __device__ __forceinline__ size_t kstep_a() const { return 128; }
    __device__ __forceinline__ size_t kstep_b() const { return 128; }
    __device__ __forceinline__ bool side_due(int) const { return false; } __device__ __forceinline__ void side() const {}
    static constexpr bool GATHER = false, FP8 = false; static constexpr int SCALE_B = 0x7f7f7f7f;
    int lda, ldb, G, c; const char *acat, *WcatT;
    __device__ __forceinline__ bool next(int i, Unit& u) const {
        constexpr int NB = P4_FP8 ? 1 : 3; const int i2 = i / NB, br = i - NB * i2, L = i2 * G + c;
        if (L >= 512) return false;
        pg8::tile_of(L, 64, 8, u.pm, u.pn); u.aux = br; return true;
    }
    __device__ __forceinline__ int k0(const Unit& u) const { return u.aux == 0 ? 0 : (u.aux == 1 ? 512 : 1536); }
    __device__ __forceinline__ const char* a_base(const Unit& u) const { return acat + ((size_t)u.pm * 256 * D + k0(u)) * 2; }
    __device__ __forceinline__ const char* b_base(const Unit& u) const { return WcatT + ((size_t)u.pn * 256 * D + k0(u)) * 2; }
    __device__ __forceinline__ int nt(const Unit& u) const { return u.aux == 1 ? 16 : 8; }
    __device__ __forceinline__ unsigned gather(const Unit&, int, int) const { return 0u; }
};
struct SchedP4b {
    __device__ __forceinline__ size_t kstep_a() const { return 128; }
    __device__ __forceinline__ size_t kstep_b() const { return 128; }
    __device__ __forceinline__ bool side_due(int) const { return false; } __device__ __forceinline__ void side() const {}
    static constexpr bool GATHER = false, FP8 = true; static constexpr int SCALE_B = 0x79797979;
    int lda, ldb, G, c; const char *acat8, *Wcat8;
    __device__ __forceinline__ bool next(int i, Unit& u) const {
        const int i2 = i >> 1, L = i2 * G + c;
        if (L >= 512) return false;
        pg8::tile_of(L, 64, 8, u.pm, u.pn); u.aux = 1 + (i & 1); return true;
    }
    __device__ __forceinline__ int k0(const Unit& u) const { return u.aux == 1 ? 0 : 1024; }
    __device__ __forceinline__ const char* a_base(const Unit& u) const { return acat8 + (size_t)u.pm * 256 * 1536 + k0(u); }
    __device__ __forceinline__ const char* b_base(const Unit& u) const { return Wcat8 + (size_t)u.pn * 256 * 1536 + k0(u); }
    __device__ __forceinline__ int nt(const Unit& u) const { return u.aux == 1 ? 8 : 4; }
    __device__ __forceinline__ unsigned gather(const Unit&, int, int) const { return 0u; }
};
struct EpiP4 {
    static constexpr bool PROBE_TWICE = false;
    static constexpr int MODE = 1;
    const bf16_t* proj; float* scr; bf16_t* merged; const unsigned char* gate8;
    __device__ __forceinline__ void operator()(const f32x4 (&acc)[2][2][4][2], const Unit& u, int wr, int wc, int fr, int fq) const {
        const int row0 = u.pm * 256 + wr * 64 + fr, cw = u.pn * 256 + wc * 64 + fq * 16, br = u.aux;
        f32x4* sp = (f32x4*)scr + (size_t)(u.pm * 8 + u.pn) * 16384 + threadIdx.x;
#pragma unroll
        for (int ai = 0; ai < 2; ++ai)
#pragma unroll
            for (int m = 0; m < 4; ++m) { const size_t row = (size_t)(row0 + ai * 128 + m * 16);
                f32x4 v[2][2];
                if (GATE_BC_FP8 && br > 0) { const u32x4 g = *(const u32x4*)(gate8 + row * (2 * D) + (br - 1) * D + cw);
                    const f32x2 a0 = __builtin_amdgcn_cvt_pk_f32_fp8((int)g.x, false), a1 = __builtin_amdgcn_cvt_pk_f32_fp8((int)g.x, true), a2 = __builtin_amdgcn_cvt_pk_f32_fp8((int)g.y, false), a3 = __builtin_amdgcn_cvt_pk_f32_fp8((int)g.y, true);
                    const f32x2 b0 = __builtin_amdgcn_cvt_pk_f32_fp8((int)g.z, false), b1 = __builtin_amdgcn_cvt_pk_f32_fp8((int)g.z, true), b2 = __builtin_amdgcn_cvt_pk_f32_fp8((int)g.w, false), b3 = __builtin_amdgcn_cvt_pk_f32_fp8((int)g.w, true);
                    v[0][0] = acc[ai][0][m][0] * (f32x4){a0.x, a0.y, a1.x, a1.y}; v[0][1] = acc[ai][0][m][1] * (f32x4){a2.x, a2.y, a3.x, a3.y};
                    v[1][0] = acc[ai][1][m][0] * (f32x4){b0.x, b0.y, b1.x, b1.y}; v[1][1] = acc[ai][1][m][1] * (f32x4){b2.x, b2.y, b3.x, b3.y};
                } else {
                const u32x4 ga = *(const u32x4*)(proj + row * IN_W + OFF_GATE + br * D + cw), gb = *(const u32x4*)(proj + row * IN_W + OFF_GATE + br * D + cw + 8);
                v[0][0] = acc[ai][0][m][0] * (f32x4){bflo(ga.x), bfhi(ga.x), bflo(ga.y), bfhi(ga.y)}; v[0][1] = acc[ai][0][m][1] * (f32x4){bflo(ga.z), bfhi(ga.z), bflo(ga.w), bfhi(ga.w)};
                v[1][0] = acc[ai][1][m][0] * (f32x4){bflo(gb.x), bfhi(gb.x), bflo(gb.y), bfhi(gb.y)}; v[1][1] = acc[ai][1][m][1] * (f32x4){bflo(gb.z), bfhi(gb.z), bflo(gb.w), bfhi(gb.w)}; }
                f32x4* s4 = sp + (size_t)((ai * 4 + m) * 4) * 512; u32x4* h4 = (u32x4*)sp + (size_t)((ai * 4 + m) * 4) * 512;
                if (P4_SMALL_FIRST) {
                    if (br != 1) { const u32x4 g = h4[0];
                        const f32x2 a0 = __builtin_amdgcn_cvt_pk_f32_fp8((int)g.x, false), a1 = __builtin_amdgcn_cvt_pk_f32_fp8((int)g.x, true), a2 = __builtin_amdgcn_cvt_pk_f32_fp8((int)g.y, false), a3 = __builtin_amdgcn_cvt_pk_f32_fp8((int)g.y, true);
                        const f32x2 b0 = __builtin_amdgcn_cvt_pk_f32_fp8((int)g.z, false), b1 = __builtin_amdgcn_cvt_pk_f32_fp8((int)g.z, true), b2 = __builtin_amdgcn_cvt_pk_f32_fp8((int)g.w, false), b3 = __builtin_amdgcn_cvt_pk_f32_fp8((int)g.w, true);
                        v[0][0] += (f32x4){a0.x, a0.y, a1.x, a1.y} * (1.0f / 16.0f); v[0][1] += (f32x4){a2.x, a2.y, a3.x, a3.y} * (1.0f / 16.0f); v[1][0] += (f32x4){b0.x, b0.y, b1.x, b1.y} * (1.0f / 16.0f); v[1][1] += (f32x4){b2.x, b2.y, b3.x, b3.y} * (1.0f / 16.0f); }
                    if (br != 0) { u32x4 o; unsigned t;
                        t = __builtin_amdgcn_cvt_pk_fp8_f32(v[0][0][0] * 16.f, v[0][0][1] * 16.f, 0u, false); o.x = __builtin_amdgcn_cvt_pk_fp8_f32(v[0][0][2] * 16.f, v[0][0][3] * 16.f, t, true);
                        t = __builtin_amdgcn_cvt_pk_fp8_f32(v[0][1][0] * 16.f, v[0][1][1] * 16.f, 0u, false); o.y = __builtin_amdgcn_cvt_pk_fp8_f32(v[0][1][2] * 16.f, v[0][1][3] * 16.f, t, true);
                        t = __builtin_amdgcn_cvt_pk_fp8_f32(v[1][0][0] * 16.f, v[1][0][1] * 16.f, 0u, false); o.z = __builtin_amdgcn_cvt_pk_fp8_f32(v[1][0][2] * 16.f, v[1][0][3] * 16.f, t, true);
                        t = __builtin_amdgcn_cvt_pk_fp8_f32(v[1][1][0] * 16.f, v[1][1][1] * 16.f, 0u, false); o.w = __builtin_amdgcn_cvt_pk_fp8_f32(v[1][1][2] * 16.f, v[1][1][3] * 16.f, t, true);
                        h4[0] = o; }
                } else if (P4_SCR_BF16) {
                    if (br > 0) { const u32x4 a = h4[0], b = h4[512];
                        v[0][0] += (f32x4){bflo(a.x), bfhi(a.x), bflo(a.y), bfhi(a.y)}; v[0][1] += (f32x4){bflo(a.z), bfhi(a.z), bflo(a.w), bfhi(a.w)};
                        v[1][0] += (f32x4){bflo(b.x), bfhi(b.x), bflo(b.y), bfhi(b.y)}; v[1][1] += (f32x4){bflo(b.z), bfhi(b.z), bflo(b.w), bfhi(b.w)}; }
                    if (br < 2) { u32x4 a, b; a.x = pk2(v[0][0][0], v[0][0][1]); a.y = pk2(v[0][0][2], v[0][0][3]); a.z = pk2(v[0][1][0], v[0][1][1]); a.w = pk2(v[0][1][2], v[0][1][3]);
                        b.x = pk2(v[1][0][0], v[1][0][1]); b.y = pk2(v[1][0][2], v[1][0][3]); b.z = pk2(v[1][1][0], v[1][1][1]); b.w = pk2(v[1][1][2], v[1][1][3]); h4[0] = a; h4[512] = b; }
                } else {
                if (br > 0) { v[0][0] += s4[0]; v[0][1] += s4[512]; v[1][0] += s4[1024]; v[1][1] += s4[1536]; }
                if (br < 2) { s4[0] = v[0][0]; s4[512] = v[0][1]; s4[1024] = v[1][0]; s4[1536] = v[1][1]; } }
                if (P4_SMALL_FIRST ? br != 0 : br < 2) {}
                else { u32x4 w0, w1; w0.x = pk2(v[0][0][0], v[0][0][1]); w0.y = pk2(v[0][0][2], v[0][0][3]); w0.z = pk2(v[0][1][0], v[0][1][1]); w0.w = pk2(v[0][1][2], v[0][1][3]);
                    w1.x = pk2(v[1][0][0], v[1][0][1]); w1.y = pk2(v[1][0][2], v[1][0][3]); w1.z = pk2(v[1][1][0], v[1][1][1]); w1.w = pk2(v[1][1][2], v[1][1][3]);
                    *(u32x4*)(merged + row * D + cw) = w0; *(u32x4*)(merged + row * D + cw + 8) = w1; } }
    }
};

struct SchedP5 {
    __device__ __forceinline__ size_t kstep_a() const { return 128; }
    __device__ __forceinline__ size_t kstep_b() const { return 128; }
    __device__ __forceinline__ bool side_due(int) const { return false; } __device__ __forceinline__ void side() const {}
    static constexpr bool GATHER = false, FP8 = false; static constexpr int SCALE_B = 0x7f7f7f7f;
    int lda, ldb, G, c; const char *A, *Bt;
    __device__ __forceinline__ bool next(int i, Unit& u) const { const int L = i * G + c; if (L >= 512) return false; pg8::tile_of(L, 64, 8, u.pm, u.pn); u.aux = 0; return true; }
    __device__ __forceinline__ const char* a_base(const Unit& u) const { return A + (size_t)u.pm * 256 * D * 2; }
    __device__ __forceinline__ const char* b_base(const Unit& u) const { return Bt + (size_t)u.pn * 256 * D * 2; }
    __device__ __forceinline__ int nt(const Unit&) const { return D / 64; }
    __device__ __forceinline__ unsigned gather(const Unit&, int, int) const { return 0u; }
};
struct EpiP5 {
    static constexpr bool PROBE_TWICE = (MK_EPI_TWICE == 5);
    static constexpr int MODE = 0;
    const float* x; float* out; bf16_t* h1b;
    __device__ __forceinline__ void operator()(const f32x4 (&acc)[2][2][4][2], const Unit& u, int wr, int wc, int fr, int fq) const {
        const int row0 = u.pm * 256 + wr * 64 + fr, col0 = u.pn * 256 + wc * 32 + 4 * fq;
#pragma unroll
        for (int ai = 0; ai < 2; ++ai) { f32x4 t[4][2][2];
#pragma unroll
            for (int m = 0; m < 4; ++m) { const size_t off = (size_t)(row0 + ai * 128 + m * 16) * D + col0;
#pragma unroll
                for (int bj = 0; bj < 2; ++bj)
#pragma unroll
                    for (int n = 0; n < 2; ++n) t[m][bj][n] = *(const f32x4*)(x + off + bj * 128 + n * 16); }
            __builtin_amdgcn_sched_barrier(0);
#pragma unroll
            for (int m = 0; m < 4; ++m) { const size_t off = (size_t)(row0 + ai * 128 + m * 16) * D + col0;
#pragma unroll
                for (int bj = 0; bj < 2; ++bj)
#pragma unroll
                    for (int n = 0; n < 2; ++n) { const f32x4 v = t[m][bj][n] + acc[ai][bj][m][n];
                        if (H1_BF16) { u32x2 o; o.x = pk2(v[0], v[1]); o.y = pk2(v[2], v[3]); *(u32x2*)(h1b + off + bj * 128 + n * 16) = o; }
                        else *(f32x4*)(out + off + bj * 128 + n * 16) = v; } }
        }
    }
};

__device__ __forceinline__ f32x4 ld4_bf16(const bf16_t* p) { const u32x2 v = *(const u32x2*)p; return (f32x4){bflo(v.x), bfhi(v.x), bflo(v.y), bfhi(v.y)}; }
#define P6_LOAD(rowoff, coloff) (H1_BF16 ? ld4_bf16(gsrcb + (size_t)(rowoff) * D + (coloff)) : *(const f32x4*)(gsrc + (size_t)(rowoff) * D + (coloff)))
__device__ __forceinline__ void p6_router(const Frame& F, const bool dry = false) {
    LAS float* part = (LAS float*)F.lds;
    LAS float* ssp = (LAS float*)(F.lds + 32768);
    LAS float* lg = (LAS float*)(F.lds + 33792);
    LAS float* rstd = (LAS float*)(F.lds + 38144);
    LAS int* lcnt = (LAS int*)(F.lds + 38400);
    LAS int* lbase = (LAS int*)(F.lds + 38656);
    const int w = F.wave, lane = F.lane, r = lane & 31, h = lane >> 5, tid = F.tid;
    for (int grp = F.bid; grp < NTOK / 32; grp += F.G) {
        const int row0 = grp * 32;
        float ss = 0.f;
        f32x16 acc;
#pragma unroll
        for (int i = 0; i < 16; ++i) acc[i] = 0.f;
        LAS float* tile = (LAS float*)(F.lds + 40960 + w * 8704);
        const float* gsrc = F.out + (size_t)(row0 + (lane >> 4)) * D + 256 * w + 4 * (lane & 15); const bf16_t* gsrcb = F.h1b + (size_t)(row0 + (lane >> 4)) * D + 256 * w + 4 * (lane & 15);
        LAS float* tw_ = tile + (lane >> 4) * 68 + 4 * (lane & 15); const LAS float* tr_ = tile + r * 68 + 8 * h;
        const bf16_t* wph = F.wrh + (size_t)r * D + 256 * w + 8 * h; const bf16_t* wpl = F.wrl + (size_t)r * D + 256 * w + 8 * h;
        f32x4 pre[8]; bf16x8 wh[4], wl[4], nh[4], nl[4];
#pragma unroll
        for (int j = 0; j < 8; ++j) pre[j] = P6_LOAD(4 * j, 0);
#pragma unroll
        for (int k = 0; k < 4; ++k) { wh[k] = *(const bf16x8*)(wph + 16 * k); wl[k] = *(const bf16x8*)(wpl + 16 * k); }
#pragma unroll 1
        for (int q = 0; q < 4; ++q) {
#pragma unroll
            for (int j = 0; j < 8; ++j) *(LAS f32x4*)(tw_ + (4 * j) * 68) = pre[j];
            if (q < 3) {
#pragma unroll
                for (int j = 0; j < 8; ++j) pre[j] = P6_LOAD(4 * j, 64 * (q + 1));
#pragma unroll
                for (int k = 0; k < 4; ++k) { nh[k] = *(const bf16x8*)(wph + 64 * (q + 1) + 16 * k); nl[k] = *(const bf16x8*)(wpl + 64 * (q + 1) + 16 * k); } }
            LDS_WAIT();
            __builtin_amdgcn_sched_barrier(0);
#pragma unroll
            for (int k = 0; k < 4; ++k) { const f32x4 xa = *(const LAS f32x4*)(tr_ + 16 * k), xb = *(const LAS f32x4*)(tr_ + 16 * k + 4);
                ss += (xa.x * xa.x + xa.y * xa.y) + (xa.z * xa.z + xa.w * xa.w) + (xb.x * xb.x + xb.y * xb.y) + (xb.z * xb.z + xb.w * xb.w);
                u32x4 ph, pl; ph.x = pk2(xa.x, xa.y); ph.y = pk2(xa.z, xa.w); ph.z = pk2(xb.x, xb.y); ph.w = pk2(xb.z, xb.w);
                pl.x = pk2(xa.x - bflo(ph.x), xa.y - bfhi(ph.x)); pl.y = pk2(xa.z - bflo(ph.y), xa.w - bfhi(ph.y)); pl.z = pk2(xb.x - bflo(ph.z), xb.y - bfhi(ph.z)); pl.w = pk2(xb.z - bflo(ph.w), xb.w - bfhi(ph.w));
                const bf16x8 xh = __builtin_bit_cast(bf16x8, ph), xl = __builtin_bit_cast(bf16x8, pl);
                acc = __builtin_amdgcn_mfma_f32_32x32x16_bf16(xh, wh[k], acc, 0, 0, 0); acc = __builtin_amdgcn_mfma_f32_32x32x16_bf16(xl, wh[k], acc, 0, 0, 0); acc = __builtin_amdgcn_mfma_f32_32x32x16_bf16(xh, wl[k], acc, 0, 0, 0); }
            LDS_WAIT();
            __builtin_amdgcn_sched_barrier(0);
            if (q < 3) {
#pragma unroll
                for (int k = 0; k < 4; ++k) { wh[k] = nh[k]; wl[k] = nl[k]; } }
        }
        ss += __shfl_xor(ss, 32);
        if (tid < 32) lcnt[tid] = 0;
        if (h == 0) ssp[w * 32 + r] = ss;
#pragma unroll
        for (int i = 0; i < 16; ++i) part[(w * 32 + (i & 3) + 8 * (i >> 2) + 4 * h) * 32 + r] = acc[i];
        __syncthreads();
        {
            const int row = tid >> 4, e0 = (tid & 15) * 2; float s0 = 0.f, s1 = 0.f, q = 0.f;
#pragma unroll
            for (int k = 0; k < 8; ++k) { s0 += part[(k * 32 + row) * 32 + e0]; s1 += part[(k * 32 + row) * 32 + e0 + 1]; q += ssp[k * 32 + row]; }
            const float rs = __builtin_amdgcn_rsqf(q * (1.f / D) + NORM_EPS);
            lg[row * 33 + e0] = s0 * rs + F.b_r[e0]; lg[row * 33 + e0 + 1] = s1 * rs + F.b_r[e0 + 1];
            if ((tid & 15) == 0) rstd[row] = rs;
        }
        __syncthreads();
        if (!dry) {
            LAS int* sel_e = (LAS int*)(F.lds + 38912); LAS float* sel_l = (LAS float*)(F.lds + 39424); LAS int* sel_r = (LAS int*)(F.lds + 39936);
            { const int row = tid >> 4, e0 = (tid & 15) * 2; const float va = lg[row * 33 + e0], vb = lg[row * 33 + e0 + 1]; int ra = 0, rb = 0;
#pragma unroll 8
              for (int e2 = 0; e2 < NE; ++e2) { const float v2 = lg[row * 33 + e2]; ra += (v2 > va || (v2 == va && e2 < e0)) ? 1 : 0; rb += (v2 > vb || (v2 == vb && e2 < e0 + 1)) ? 1 : 0; }
              if (ra < 4) { sel_e[row * 4 + ra] = e0; sel_l[row * 4 + ra] = va; }
              if (rb < 4) { sel_e[row * 4 + rb] = e0 + 1; sel_l[row * 4 + rb] = vb; } }
            __syncthreads();
            if (tid < 128) sel_r[tid] = __hip_atomic_fetch_add(&lcnt[sel_e[tid]], 1, __ATOMIC_RELAXED, __HIP_MEMORY_SCOPE_WORKGROUP);
            __syncthreads();
            if (tid < 32) { const int c = lcnt[tid]; lbase[tid] = c ? (int)atomicAdd(F.ctl + CW_CNT + 64 * tid, (unsigned)c) : 0; }
            __syncthreads();
            if (tid < 128) { const int row = tid >> 2, k = tid & 3, e = sel_e[tid], t = row0 + row; const float l0 = sel_l[row * 4];
                const float e1 = __expf(sel_l[row * 4 + 1] - l0), e2 = __expf(sel_l[row * 4 + 2] - l0), e3 = __expf(sel_l[row * 4 + 3] - l0), inv = 1.0f / (1.0f + e1 + e2 + e3);
                const float wk = (k == 0 ? 1.0f : (k == 1 ? e1 : (k == 2 ? e2 : e3))) * inv; const int rank = lbase[e] + sel_r[tid];
                F.list[(size_t)e * CAP + rank] = t; F.er[t * 4 + k] = ((unsigned)e << 16) | (unsigned)rank; F.tw[t * 4 + k] = wk; ((LAS int*)(F.lds + 40448))[tid] = (e << 16) | rank; }
            if (XN2_PREGATHER) __syncthreads();
        }
        {
            const f32x4 g = *(const f32x4*)(F.g2 + 256 * w + 4 * lane); const float* xp = F.out + (size_t)row0 * D + 256 * w + 4 * lane; const bf16_t* xpb = F.h1b + (size_t)row0 * D + 256 * w + 4 * lane;
            unsigned char* op8 = (unsigned char*)F.xn2 + (size_t)row0 * D + 256 * w + 4 * lane; bf16_t* op = F.xn2 + (size_t)row0 * D + 256 * w + 4 * lane;
#pragma unroll 32
            for (int j = 0; j < 32; ++j) { const f32x4 xv = H1_BF16 ? ld4_bf16(xpb + (size_t)j * D) : *(const f32x4*)(xp + (size_t)j * D); const float rs = rstd[j];
                if constexpr (MOE_FP8) { const unsigned t = __builtin_amdgcn_cvt_pk_fp8_f32(xv.x * rs * g.x, xv.y * rs * g.y, 0u, false); const unsigned wq = __builtin_amdgcn_cvt_pk_fp8_f32(xv.z * rs * g.z, xv.w * rs * g.w, t, true);
                    if (XN2_PREGATHER) {
#pragma unroll
                        for (int k = 0; k < 4; ++k) { const int sl = ((const LAS int*)(F.lds + 40448))[j * 4 + k];
                            *(unsigned*)(F.xg + ((size_t)((sl >> 16) * 16 + 2 * w + (lane >> 5)) * CAP + (sl & 0xffff)) * 128 + ((4 * lane) & 127)) = wq; } }
                    else *(unsigned*)(op8 + (size_t)j * D) = wq; }
                else { u32x2 o; o.x = pk2(xv.x * rs * g.x, xv.y * rs * g.y); o.y = pk2(xv.z * rs * g.z, xv.w * rs * g.w); *(u32x2*)(op + (size_t)j * D) = o; } }
        }
        __syncthreads();
    }
}

__device__ __forceinline__ void moe_tables(const Frame& F) {
    LAS int* cntL = (LAS int*)(F.lds + L_CNT); LAS int* mbst = (LAS int*)(F.lds + L_MBST); LAS int* nmbp = (LAS int*)(F.lds + L_NMB); LAS int* mbe = (LAS int*)(F.lds + L_MBE); LAS int* mbr0 = (LAS int*)(F.lds + L_MBR0);
    __syncthreads();
    if (F.wave == 0) {
        const int lane = F.lane, c = lane < NE ? (int)F.ctl[CW_CNT + 64 * lane] : 0, n = (c + 255) >> 8; int incl = n;
#pragma unroll
        for (int o = 1; o < 32; o <<= 1) { const int v = __shfl_up(incl, o); if (lane >= o) incl += v; }
        if (lane < NE) { cntL[lane] = c; mbst[lane] = incl - n; }
        if (lane == NE - 1) { mbst[NE] = incl; nmbp[0] = incl; }
    }
    __syncthreads();
    const int nmb = nmbp[0];
    for (int t = F.tid; t < nmb; t += 512) {
        int e = 0;
#pragma unroll 8
        for (int e2 = 1; e2 < NE; ++e2) e += (mbst[e2] <= t) ? 1 : 0;
        mbe[t] = e; mbr0[t] = 256 * (t - mbst[e]); }
    __syncthreads();
}

struct SchedP7 {
    __device__ __forceinline__ size_t kstep_a() const { return XN2_PREGATHER ? (size_t)CAP * 128 : 128; }
    __device__ __forceinline__ bool side_due(int) const { return false; } __device__ __forceinline__ void side() const {}
    static constexpr bool GATHER = !XN2_PREGATHER, FP8 = MOE_FP8 != 0; static constexpr int SCALE_B = 0x79797979;
    int lda, ldb, G, c, nmb; const char *xn2, *WupT; const int* list; LAS unsigned char* lds;
    __device__ __forceinline__ bool next(int i, Unit& u) const { const int L = i * G + c; if (L >= nmb * 16) return false; pg8::tile_of(L, nmb, 16, u.pm, u.pn, MOE_WGM); u.aux = ((const LAS int*)(lds + L_MBE))[u.pm]; return true; }
    __device__ __forceinline__ const char* a_base(const Unit& u) const { return XN2_PREGATHER ? xn2 + ((size_t)(u.aux * 16) * CAP + ((const LAS int*)(lds + L_MBR0))[u.pm]) * 128 : xn2; }
    __device__ __forceinline__ size_t kstep_b() const { return MOE_W_KTILE_MAJOR ? (size_t)2 * DFF * 128 : 128; }
    __device__ __forceinline__ const char* b_base(const Unit& u) const { return MOE_W_KTILE_MAJOR ? WupT + (size_t)u.aux * 2 * DFF * D + (size_t)u.pn * 256 * 128 : WupT + ((size_t)u.aux * 2 * DFF + (size_t)u.pn * 256) * D * MOE_EB; }
    __device__ __forceinline__ int nt(const Unit&) const { return D * MOE_EB / 128; }
    __device__ __forceinline__ unsigned gather(const Unit& u, int R, int C2) const {
        const int r0 = ((const LAS int*)(lds + L_MBR0))[u.pm], cnt = ((const LAS int*)(lds + L_CNT))[u.aux], row = r0 + R;
        const int tok = row < cnt ? list[(size_t)u.aux * CAP + row] : 0;
        return (unsigned)tok * (unsigned)(D * MOE_EB) + (unsigned)C2;
    }
};
struct EpiP7 {
    static constexpr bool PROBE_TWICE = (MK_EPI_TWICE == 7);
    static constexpr int MODE = 1;
    const float* b_up; bf16_t* act;
    __device__ __forceinline__ void operator()(const f32x4 (&acc)[2][2][4][2], const Unit& u, int wr, int wc, int fr, int fq) const {
        const int row0 = u.pm * 256 + wr * 64 + fr, cw = u.pn * 256 + wc * 64 + fq * 16;
        f32x4 bv[2][2];
#pragma unroll
        for (int bj = 0; bj < 2; ++bj)
#pragma unroll
            for (int n = 0; n < 2; ++n) bv[bj][n] = *(const f32x4*)(b_up + (size_t)u.aux * 2 * DFF + cw + bj * 8 + n * 4);
#pragma unroll
        for (int ai = 0; ai < 2; ++ai)
#pragma unroll
            for (int m = 0; m < 4; ++m) { float a8[8];
#pragma unroll
                for (int bj = 0; bj < 2; ++bj)
#pragma unroll
                    for (int n = 0; n < 2; ++n) { const f32x4 v = acc[ai][bj][m][n] + bv[bj][n];
#pragma unroll
                        for (int p = 0; p < 2; ++p) { const float g = fminf(v[2 * p], 7.0f), up = fminf(fmaxf(v[2 * p + 1], -7.0f), 7.0f);
                            a8[bj * 4 + n * 2 + p] = g * fast_sigmoid(1.702f * g) * (up + 1.0f); } }
                if constexpr (MOE_FP8) { u32x2 w; unsigned t;
                    t = __builtin_amdgcn_cvt_pk_fp8_f32(a8[0], a8[1], 0u, false); w.x = __builtin_amdgcn_cvt_pk_fp8_f32(a8[2], a8[3], t, true);
                    t = __builtin_amdgcn_cvt_pk_fp8_f32(a8[4], a8[5], 0u, false); w.y = __builtin_amdgcn_cvt_pk_fp8_f32(a8[6], a8[7], t, true);
                    if (ACT_KTILE_MAJOR) *(u32x2*)((unsigned char*)act + ((size_t)u.pn * NSLOT + (row0 + ai * 128 + m * 16)) * 128 + ((cw >> 1) & 127)) = w;
                    else *(u32x2*)((unsigned char*)act + (size_t)(row0 + ai * 128 + m * 16) * DFF + (cw >> 1)) = w; }
                else { u32x4 w; w.x = pk2(a8[0], a8[1]); w.y = pk2(a8[2], a8[3]); w.z = pk2(a8[4], a8[5]); w.w = pk2(a8[6], a8[7]);
                    *(u32x4*)(act + (size_t)(row0 + ai * 128 + m * 16) * DFF + (cw >> 1)) = w; } }
    }
};

struct SchedP8 {
    __device__ __forceinline__ bool side_due(int) const { return false; } __device__ __forceinline__ void side() const {}
    static constexpr bool GATHER = false, FP8 = MOE_FP8 != 0; static constexpr int SCALE_B = 0x79797979;
    int lda, ldb, G, c, nmb; const char *act, *WdnT; LAS unsigned char* lds;
    __device__ __forceinline__ bool next(int i, Unit& u) const { const int L = i * G + c; if (L >= nmb * 8) return false; pg8::tile_of(L, nmb, 8, u.pm, u.pn, MOE_WGM_DN); u.aux = ((const LAS int*)(lds + L_MBE))[u.pm]; return true; }
    __device__ __forceinline__ size_t kstep_a() const { return ACT_KTILE_MAJOR ? (size_t)NSLOT * 128 : 128; }
    __device__ __forceinline__ const char* a_base(const Unit& u) const { return ACT_KTILE_MAJOR ? act + (size_t)u.pm * 256 * 128 : act + (size_t)u.pm * 256 * DFF * MOE_EB; }
    __device__ __forceinline__ size_t kstep_b() const { return MOE_W_KTILE_MAJOR ? (size_t)D * 128 : 128; }
    __device__ __forceinline__ const char* b_base(const Unit& u) const { return MOE_W_KTILE_MAJOR ? WdnT + (size_t)u.aux * D * DFF + (size_t)u.pn * 256 * 128 : WdnT + ((size_t)u.aux * D + (size_t)u.pn * 256) * DFF * MOE_EB; }
    __device__ __forceinline__ int nt(const Unit&) const { return DFF * MOE_EB / 128; }
    __device__ __forceinline__ unsigned gather(const Unit&, int, int) const { return 0u; }
};
struct EpiP8 {
    static constexpr bool PROBE_TWICE = (MK_EPI_TWICE == 8);
    static constexpr int MODE = 1;
    const float* b_dn; bf16_t* ybuf;
    __device__ __forceinline__ void operator()(const f32x4 (&acc)[2][2][4][2], const Unit& u, int wr, int wc, int fr, int fq) const {
        const int row0 = u.pm * 256 + wr * 64 + fr, cw = u.pn * 256 + wc * 64 + fq * 16;
        f32x4 bv[2][2];
#pragma unroll
        for (int bj = 0; bj < 2; ++bj)
#pragma unroll
            for (int n = 0; n < 2; ++n) bv[bj][n] = *(const f32x4*)(b_dn + (size_t)u.aux * D + cw + bj * 8 + n * 4);
#pragma unroll
        for (int ai = 0; ai < 2; ++ai)
#pragma unroll
            for (int m = 0; m < 4; ++m) { bf16_t* rowp = ybuf + (size_t)(row0 + ai * 128 + m * 16) * D + cw;
                if (YBUF_FP8) { u32x4 w; unsigned t; const f32x4 a0 = acc[ai][0][m][0] + bv[0][0], a1 = acc[ai][0][m][1] + bv[0][1], a2 = acc[ai][1][m][0] + bv[1][0], a3 = acc[ai][1][m][1] + bv[1][1];
                    t = __builtin_amdgcn_cvt_pk_fp8_f32(a0[0], a0[1], 0u, false); w.x = __builtin_amdgcn_cvt_pk_fp8_f32(a0[2], a0[3], t, true);
                    t = __builtin_amdgcn_cvt_pk_fp8_f32(a1[0], a1[1], 0u, false); w.y = __builtin_amdgcn_cvt_pk_fp8_f32(a1[2], a1[3], t, true);
                    t = __builtin_amdgcn_cvt_pk_fp8_f32(a2[0], a2[1], 0u, false); w.z = __builtin_amdgcn_cvt_pk_fp8_f32(a2[2], a2[3], t, true);
                    t = __builtin_amdgcn_cvt_pk_fp8_f32(a3[0], a3[1], 0u, false); w.w = __builtin_amdgcn_cvt_pk_fp8_f32(a3[2], a3[3], t, true);
                    *(u32x4*)((unsigned char*)ybuf + (size_t)(row0 + ai * 128 + m * 16) * D + cw) = w; }
                else {
#pragma unroll
                for (int bj = 0; bj < 2; ++bj) { const f32x4 v0 = acc[ai][bj][m][0] + bv[bj][0], v1 = acc[ai][bj][m][1] + bv[bj][1];
                    u32x4 w; w.x = pk2(v0[0], v0[1]); w.y = pk2(v0[2], v0[3]); w.z = pk2(v1[0], v1[1]); w.w = pk2(v1[2], v1[3]);
                    *(u32x4*)(rowp + bj * 8) = w; } } }
    }
};

__device__ __forceinline__ void p9_combine(const Frame& F, const bool dry = false) {
    const LAS int* mbst = (const LAS int*)(F.lds + L_MBST);
    const int gw = F.bid * 8 + F.wave, NGW = F.G * 8, lane = F.lane;
    for (int t = gw; t < NTOK; t += NGW) {
        const bf16_t* yp[4]; const unsigned char* yp8[4]; float wk[4];
#pragma unroll
        for (int k = 0; k < 4; ++k) { const unsigned erv = F.er[t * 4 + k]; const int e = (int)(erv >> 16), rank = (int)(erv & 0xffffu);
            yp[k] = F.ybuf + (size_t)(256 * mbst[e] + rank) * D + lane * 8; yp8[k] = (const unsigned char*)F.ybuf + (size_t)(256 * mbst[e] + rank) * D + lane * 8; wk[k] = F.tw[t * 4 + k]; }
        float* op = F.out + (size_t)t * D + lane * 8; const bf16_t* hp = F.h1b + (size_t)t * D + lane * 8;
#pragma unroll
        for (int st = 0; st < 4; ++st) {
            f32x4 o0, o1;
            if (H1_BF16) { const u32x4 hv = *(const u32x4*)(hp + 512 * st); o0 = (f32x4){bflo(hv.x), bfhi(hv.x), bflo(hv.y), bfhi(hv.y)}; o1 = (f32x4){bflo(hv.z), bfhi(hv.z), bflo(hv.w), bfhi(hv.w)}; }
            else { o0 = *(const f32x4*)(op + 512 * st); o1 = *(const f32x4*)(op + 512 * st + 4); }
#pragma unroll
            for (int k = 0; k < 4; ++k) { const float wv = wk[k];
                if (YBUF_FP8) { const u32x2 y = *(const u32x2*)(yp8[k] + 512 * st);
                    const f32x2 a = __builtin_amdgcn_cvt_pk_f32_fp8((int)y.x, false), b = __builtin_amdgcn_cvt_pk_f32_fp8((int)y.x, true), c = __builtin_amdgcn_cvt_pk_f32_fp8((int)y.y, false), d = __builtin_amdgcn_cvt_pk_f32_fp8((int)y.y, true);
                    o0 += wv * (f32x4){a.x, a.y, b.x, b.y}; o1 += wv * (f32x4){c.x, c.y, d.x, d.y}; }
                else { const u32x4 y = *(const u32x4*)(yp[k] + 512 * st);
                    o0 += wv * (f32x4){bflo(y.x), bfhi(y.x), bflo(y.y), bfhi(y.y)}; o1 += wv * (f32x4){bflo(y.z), bfhi(y.z), bflo(y.w), bfhi(y.w)}; } }
            if (dry) { asm volatile("" :: "v"(o0), "v"(o1)); o0 = *(const f32x4*)(op + 512 * st); o1 = *(const f32x4*)(op + 512 * st + 4); asm volatile("" : "+v"(o0), "+v"(o1)); }
            __builtin_nontemporal_store(o0, (f32x4*)(op + 512 * st)); __builtin_nontemporal_store(o1, (f32x4*)(op + 512 * st + 4));
        }
    }
}


#ifndef MK_NAIVE
#define MK_NAIVE 0
#endif
#ifndef MK_FAST
#define MK_FAST 0x3ff
#endif
#if MK_NAIVE
namespace nv {
__device__ __forceinline__ float sigm(float x) { return 1.0f / (1.0f + __expf(-x)); }
__global__ void __launch_bounds__(256) k_rms(const float* x, const float* g, bf16_t* o) {
    __shared__ float red[256];
    const int row = blockIdx.x, tid = threadIdx.x; const float* xr = x + (size_t)row * D;
    float s = 0.f; for (int i = tid; i < D; i += 256) s += xr[i] * xr[i];
    red[tid] = s; __syncthreads();
    for (int o2 = 128; o2 > 0; o2 >>= 1) { if (tid < o2) red[tid] += red[tid + o2]; __syncthreads(); }
    const float r = 1.0f / sqrtf(red[0] / D + NORM_EPS);
    for (int i = tid; i < D; i += 256) o[(size_t)row * D + i] = f2bf(xr[i] * r * g[i]);
}
template <class P> __global__ void __launch_bounds__(256) k_gemm(P p) {
    __shared__ float As[16][65], Bs[16][65];
    const int tid = threadIdx.x, tx = tid & 15, ty = tid >> 4, z = blockIdx.z;
    const int M = p.rows(z), m0 = blockIdx.y * 64, n0 = blockIdx.x * 64;
    if (m0 >= M) return;
    const int base = p.base(z);
    float acc[4][4];
#pragma unroll
    for (int i = 0; i < 4; ++i)
#pragma unroll
        for (int j = 0; j < 4; ++j) acc[i][j] = 0.f;
    for (int k0 = 0; k0 < p.K; k0 += 16) {
#pragma unroll
        for (int i = 0; i < 4; ++i) { const int idx = tid + 256 * i, m = idx >> 4, k = idx & 15; As[k][m] = (m0 + m < M) ? p.a(z, base, m0 + m, k0 + k) : 0.f; }
#pragma unroll
        for (int i = 0; i < 4; ++i) { const int idx = tid + 256 * i, k = idx >> 6, n = idx & 63; Bs[k][n] = p.b(z, k0 + k, n0 + n); }
        __syncthreads();
#pragma unroll
        for (int k = 0; k < 16; ++k) { float a[4], b[4];
#pragma unroll
            for (int i = 0; i < 4; ++i) { a[i] = As[k][ty * 4 + i]; b[i] = Bs[k][tx * 4 + i]; }
#pragma unroll
            for (int i = 0; i < 4; ++i)
#pragma unroll
                for (int j = 0; j < 4; ++j) acc[i][j] += a[i] * b[j]; }
        __syncthreads();
    }
#pragma unroll
    for (int i = 0; i < 4; ++i) { const int m = m0 + ty * 4 + i; if (m < M) p.epi(z, base, m, n0 + tx * 4, acc[i][0], acc[i][1], acc[i][2], acc[i][3]); }
}
struct PIn { const bf16_t* xn; const float* w; const float* b_gate; bf16_t* proj; int K, pad;
    __device__ int rows(int) const { return NTOK; } __device__ int base(int) const { return 0; }
    __device__ float a(int, int, int m, int k) const { return bf2f(xn[(size_t)m * D + k]); }
    __device__ float b(int, int k, int n) const { return w[(size_t)k * IN_W + n]; }
    __device__ void epi(int, int, int m, int n0, float v0, float v1, float v2, float v3) const { float v[4] = {v0, v1, v2, v3};
#pragma unroll
        for (int j = 0; j < 4; ++j) { const int n = n0 + j; float y = v[j]; if (n >= OFF_GATE) y = sigm(y + b_gate[n - OFF_GATE]); proj[(size_t)m * IN_W + n] = f2bf(y); } } };
struct PMkv { const bf16_t* mn; const float* w; bf16_t* kvraw; int K, pad;
    __device__ int rows(int) const { return NMEMROW; } __device__ int base(int) const { return 0; }
    __device__ float a(int, int, int m, int k) const { return bf2f(mn[(size_t)m * D + k]); }
    __device__ float b(int, int k, int n) const { return w[(size_t)k * 1024 + n]; }
    __device__ void epi(int, int, int m, int n0, float v0, float v1, float v2, float v3) const { float v[4] = {v0, v1, v2, v3};
#pragma unroll
        for (int j = 0; j < 4; ++j) kvraw[(size_t)m * 1024 + n0 + j] = f2bf(v[j]); } };
struct PBr { const float* af; const bf16_t* ab; int lda, aoff; const float* w; const bf16_t* proj; float* tmp; bf16_t* merged; int br, K;
    __device__ int rows(int) const { return NTOK; } __device__ int base(int) const { return 0; }
    __device__ float a(int, int, int m, int k) const { return af ? af[(size_t)m * lda + aoff + k] : bf2f(ab[(size_t)m * lda + aoff + k]); }
    __device__ float b(int, int k, int n) const { return w[(size_t)k * D + n]; }
    __device__ void epi(int, int, int m, int n0, float v0, float v1, float v2, float v3) const { float v[4] = {v0, v1, v2, v3};
#pragma unroll
        for (int j = 0; j < 4; ++j) { const int n = n0 + j; float y = v[j] * bf2f(proj[(size_t)m * IN_W + OFF_GATE + br * D + n]);
            if (br > 0) y += tmp[(size_t)m * D + n];
            if (br < 2) tmp[(size_t)m * D + n] = y; else merged[(size_t)m * D + n] = f2bf(y); } } };
struct POut { const bf16_t* merged; const float* w; const float* x; float* out; int K, pad;
    __device__ int rows(int) const { return NTOK; } __device__ int base(int) const { return 0; }
    __device__ float a(int, int, int m, int k) const { return bf2f(merged[(size_t)m * D + k]); }
    __device__ float b(int, int k, int n) const { return w[(size_t)k * D + n]; }
    __device__ void epi(int, int, int m, int n0, float v0, float v1, float v2, float v3) const { float v[4] = {v0, v1, v2, v3};
#pragma unroll
        for (int j = 0; j < 4; ++j) out[(size_t)m * D + n0 + j] = x[(size_t)m * D + n0 + j] + v[j]; } };
__device__ __forceinline__ int mb_base(const unsigned* ctl, int e) { int mb = 0; for (int i = 0; i < e; ++i) mb += ((int)ctl[CW_CNT + 64 * i] + 255) >> 8; return mb * 256; }
struct PUp { const bf16_t* xn2; const int* list; const unsigned* ctl; const float* w; const float* bias; bf16_t* act; int K, pad;
    __device__ int rows(int z) const { return (int)ctl[CW_CNT + 64 * z]; } __device__ int base(int z) const { return mb_base(ctl, z); }
    __device__ float a(int z, int, int m, int k) const { return bf2f(xn2[(size_t)list[(size_t)z * CAP + m] * D + k]); }
    __device__ float b(int z, int k, int n) const { return w[((size_t)z * D + k) * (2 * DFF) + n]; }
    __device__ void epi(int z, int base, int m, int n0, float v0, float v1, float v2, float v3) const { float v[4] = {v0, v1, v2, v3};
#pragma unroll
        for (int p = 0; p < 2; ++p) { const float g = fminf(v[2 * p] + bias[(size_t)z * 2 * DFF + n0 + 2 * p], 7.0f), u = fminf(fmaxf(v[2 * p + 1] + bias[(size_t)z * 2 * DFF + n0 + 2 * p + 1], -7.0f), 7.0f);
            act[(size_t)(base + m) * DFF + (n0 >> 1) + p] = f2bf(g * sigm(1.702f * g) * (u + 1.0f)); } } };
struct PDn { const bf16_t* act; const unsigned* ctl; const float* w; const float* bias; bf16_t* ybuf; int K, pad;
    __device__ int rows(int z) const { return (int)ctl[CW_CNT + 64 * z]; } __device__ int base(int z) const { return mb_base(ctl, z); }
    __device__ float a(int, int base, int m, int k) const { return bf2f(act[(size_t)(base + m) * DFF + k]); }
    __device__ float b(int z, int k, int n) const { return w[((size_t)z * DFF + k) * D + n]; }
    __device__ void epi(int z, int base, int m, int n0, float v0, float v1, float v2, float v3) const { float v[4] = {v0, v1, v2, v3};
#pragma unroll
        for (int j = 0; j < 4; ++j) ybuf[(size_t)(base + m) * D + n0 + j] = f2bf(v[j] + bias[(size_t)z * D + n0 + j]); } };
__global__ void __launch_bounds__(256) k_heads(const bf16_t* proj, const int* pos, const float* gq, const float* gk, const float* gmq, bf16_t* qn, bf16_t* kn, bf16_t* mqn) {
    const int i = blockIdx.x * 256 + threadIdx.x; if (i >= NTOK * 14) return;
    const int t = i / 14, h = i % 14;
    const bf16_t* src; const float* g; bf16_t* dst; bool rot; float sc;
    if (h < 8) { src = proj + (size_t)t * IN_W + OFF_Q + h * 128; g = gq; dst = qn + (size_t)t * 1024 + h * 128; rot = true; sc = QSCALE; }
    else if (h < 10) { src = proj + (size_t)t * IN_W + OFF_K + (h - 8) * 128; g = gk; dst = kn + (size_t)t * 256 + (h - 8) * 128; rot = true; sc = 1.0f; }
    else { src = proj + (size_t)t * IN_W + OFF_MQ + (h - 10) * 128; g = gmq; dst = mqn + (size_t)t * 512 + (h - 10) * 128; rot = false; sc = QSCALE; }
    float ss = 0.f; for (int d = 0; d < 128; ++d) { const float v = bf2f(src[d]); ss += v * v; }
    const float r = 1.0f / sqrtf(ss / 128.f + NORM_EPS), p = (float)pos[t];
    for (int d = 0; d < 64; ++d) {
        const float y1 = bf2f(src[d]) * r * g[d], y2 = bf2f(src[d + 64]) * r * g[d + 64];
        if (rot) { const float inv_freq = powf(10000.0f, -(float)d * (2.0f / 128.0f)), ang = p * inv_freq, c = cosf(ang), s = sinf(ang);
            dst[d] = f2bf((y1 * c - y2 * s) * sc); dst[d + 64] = f2bf((y2 * c + y1 * s) * sc); }
        else { dst[d] = f2bf(y1 * sc); dst[d + 64] = f2bf(y2 * sc); }
    }
}
__global__ void __launch_bounds__(256) k_memk(const bf16_t* kvraw, const float* gmk, bf16_t* mk, bf16_t* mvT) {
    const int i = blockIdx.x * 256 + threadIdx.x; if (i >= NMEMROW * 4) return;
    const int r = i >> 2, h = i & 3, b = r / MEMLEN, j = r % MEMLEN; const bf16_t* src = kvraw + (size_t)r * 1024 + h * 128;
    float ss = 0.f; for (int d = 0; d < 128; ++d) { const float v = bf2f(src[d]); ss += v * v; }
    const float q = 1.0f / sqrtf(ss / 128.f + NORM_EPS);
    for (int d = 0; d < 128; ++d) { mk[(size_t)r * 512 + h * 128 + d] = f2bf(bf2f(src[d]) * q * gmk[d]); mvT[((size_t)((b * 4 + h) * 128 + d)) * MEMLEN + j] = src[512 + d]; }
}
__global__ void __launch_bounds__(256) k_vT(const bf16_t* proj, bf16_t* vT) {
    const size_t i = (size_t)blockIdx.x * 256 + threadIdx.x; if (i >= (size_t)NTOK * 256) return;
    const int c = (int)(i & 255), t = (int)(i >> 8), b = t / SEQ, s = t % SEQ;
    vT[((size_t)(b * 256 + c)) * SEQ + s] = proj[(size_t)t * IN_W + OFF_V + c];
}
__global__ void __launch_bounds__(256) k_pool(const bf16_t* proj, bf16_t* acat) {
    const size_t i = (size_t)blockIdx.x * 256 + threadIdx.x; if (i >= (size_t)NTOK * 512) return;
    const int c = (int)(i & 511), t = (int)(i >> 9), b = t / SEQ, s = t % SEQ, g = c >> 7, w = 2 << g;
    int lo = s - w / 2, hi = lo + w; lo = lo < 0 ? 0 : lo; hi = hi > SEQ ? SEQ : hi;
    float a = 0.f; for (int j = lo; j < hi; ++j) a += bf2f(proj[(size_t)(b * SEQ + j) * IN_W + OFF_POOL + c]);
    acat[(size_t)t * D + c] = f2bf(a / (float)(hi - lo) - bf2f(proj[(size_t)t * IN_W + OFF_POOL + c]));
}
__global__ void __launch_bounds__(256) k_attn(const bf16_t* qn, const bf16_t* kn, const bf16_t* vT, const bf16_t* mqn, const bf16_t* mk, const bf16_t* mvT, const float* sink, bf16_t* acat) {
    const int wv = blockIdx.x * 4 + (threadIdx.x >> 6), lane = threadIdx.x & 63; if (wv >= NTOK * 12) return;
    const int t = wv / 12, h = wv % 12, b = t / SEQ, s = t % SEQ;
    float q1, q2, m, l, o1 = 0.f, o2 = 0.f;
    if (h < 8) { const int kvh = h >> 2; q1 = bf2f(qn[(size_t)t * 1024 + h * 128 + lane]); q2 = bf2f(qn[(size_t)t * 1024 + h * 128 + 64 + lane]); m = sink[h] * LOG2E; l = 1.0f;
        int lo = s - 128, hi = s + 128; lo = lo < 0 ? 0 : lo; hi = hi > SEQ - 1 ? SEQ - 1 : hi;
        for (int j = lo; j <= hi; ++j) { const bf16_t* kr = kn + (size_t)(b * SEQ + j) * 256 + kvh * 128;
            const float sc = wave_sum(q1 * bf2f(kr[lane]) + q2 * bf2f(kr[64 + lane])), mn = fmaxf(m, sc), al = exp2f(m - mn), p = exp2f(sc - mn);
            l = l * al + p; o1 = o1 * al + p * bf2f(vT[((size_t)((b * 2 + kvh) * 128 + lane)) * SEQ + j]); o2 = o2 * al + p * bf2f(vT[((size_t)((b * 2 + kvh) * 128 + 64 + lane)) * SEQ + j]); m = mn; }
        acat[(size_t)t * D + 512 + h * 128 + lane] = f2bf(o1 / l); acat[(size_t)t * D + 512 + h * 128 + 64 + lane] = f2bf(o2 / l);
    } else { const int hm = h - 8; q1 = bf2f(mqn[(size_t)t * 512 + hm * 128 + lane]); q2 = bf2f(mqn[(size_t)t * 512 + hm * 128 + 64 + lane]); m = -1e30f; l = 0.f;
        for (int j = 0; j < MEMLEN; ++j) { const bf16_t* kr = mk + (size_t)(b * MEMLEN + j) * 512 + hm * 128;
            const float sc = wave_sum(q1 * bf2f(kr[lane]) + q2 * bf2f(kr[64 + lane])), mn = fmaxf(m, sc), al = exp2f(m - mn), p = exp2f(sc - mn);
            l = l * al + p; o1 = o1 * al + p * bf2f(mvT[((size_t)((b * 4 + hm) * 128 + lane)) * MEMLEN + j]); o2 = o2 * al + p * bf2f(mvT[((size_t)((b * 4 + hm) * 128 + 64 + lane)) * MEMLEN + j]); m = mn; }
        acat[(size_t)t * D + 1536 + hm * 128 + lane] = f2bf(o1 / l); acat[(size_t)t * D + 1536 + hm * 128 + 64 + lane] = f2bf(o2 / l);
    }
}
__global__ void __launch_bounds__(256) k_a2(const bf16_t* acat, const float* w_pg, const float* pool_scale, float* a2) {
    const size_t i = (size_t)blockIdx.x * 256 + threadIdx.x; if (i >= (size_t)NTOK * 512) return;
    const int n = (int)(i & 511), t = (int)(i >> 9), g = n >> 7, d = n & 127;
    float a = 0.f; for (int c = 0; c < 128; ++c) a += bf2f(acat[(size_t)t * D + g * 128 + c]) * w_pg[(size_t)(g * 128 + c) * 128 + d];
    a2[(size_t)t * 512 + n] = a * pool_scale[n];
}
__global__ void __launch_bounds__(256) k_router(const float* h1, const float* g2, const float* w_r, const float* b_r, bf16_t* xn2, unsigned* ctl, int* list, unsigned* er, float* tw) {
    const int t = blockIdx.x * 4 + (threadIdx.x >> 6), lane = threadIdx.x & 63; if (t >= NTOK) return;
    const float* hr = h1 + (size_t)t * D;
    float ss = 0.f; for (int j = 0; j < 32; ++j) { const float v = hr[lane + 64 * j]; ss += v * v; }
    const float rs = 1.0f / sqrtf(wave_sum(ss) / D + NORM_EPS);
    float acc[32];
#pragma unroll
    for (int e = 0; e < 32; ++e) acc[e] = 0.f;
    for (int j = 0; j < 32; ++j) { const int k = lane + 64 * j; const float y = hr[k] * rs * g2[k]; xn2[(size_t)t * D + k] = f2bf(y);
        const f32x4* wr = (const f32x4*)(w_r + (size_t)k * 32);
#pragma unroll
        for (int e4 = 0; e4 < 8; ++e4) { const f32x4 w4 = wr[e4]; acc[4 * e4] += y * w4.x; acc[4 * e4 + 1] += y * w4.y; acc[4 * e4 + 2] += y * w4.z; acc[4 * e4 + 3] += y * w4.w; } }
#pragma unroll
    for (int e = 0; e < 32; ++e) acc[e] = wave_sum(acc[e]) + b_r[e];
    int te[4]; float tl[4]; unsigned taken = 0u;
#pragma unroll
    for (int k = 0; k < 4; ++k) { float best = -3.0e38f; int bi = 0;
#pragma unroll
        for (int e = 0; e < 32; ++e) { const bool ok = !((taken >> e) & 1u) && acc[e] > best; best = ok ? acc[e] : best; bi = ok ? e : bi; }
        taken |= 1u << bi; te[k] = bi; tl[k] = best; }
    if (lane == 0) {
        const float e1 = expf(tl[1] - tl[0]), e2 = expf(tl[2] - tl[0]), e3 = expf(tl[3] - tl[0]), inv = 1.0f / (1.0f + e1 + e2 + e3);
        const float w4[4] = {inv, e1 * inv, e2 * inv, e3 * inv};
#pragma unroll
        for (int k = 0; k < 4; ++k) { const unsigned rank = atomicAdd(ctl + CW_CNT + 64 * te[k], 1u); list[(size_t)te[k] * CAP + rank] = t; er[t * 4 + k] = ((unsigned)te[k] << 16) | rank; tw[t * 4 + k] = w4[k]; }
    }
}
__global__ void __launch_bounds__(256) k_combine(const unsigned* ctl, const unsigned* er, const float* tw, const bf16_t* ybuf, float* out) {
    __shared__ int slot[4]; __shared__ float wk[4];
    const int t = blockIdx.x, tid = threadIdx.x;
    if (tid < 4) { const unsigned v = er[t * 4 + tid]; slot[tid] = mb_base(ctl, (int)(v >> 16)) + (int)(v & 0xffffu); wk[tid] = tw[t * 4 + tid]; }
    __syncthreads();
    for (int n = tid; n < D; n += 256) { float a = out[(size_t)t * D + n];
        for (int k = 0; k < 4; ++k) a += wk[k] * bf2f(ybuf[(size_t)slot[k] * D + n]);
        out[(size_t)t * D + n] = a; }
}
}
#endif

constexpr int NPH = 10;
__global__ void __launch_bounds__(512, 2) fwd(Args args) {
    extern __shared__ __attribute__((aligned(16))) unsigned char lds_raw[];
    Frame F;
    F.lds = (LAS unsigned char*)lds_raw; F.tid = threadIdx.x; F.lane = F.tid & 63; F.wave = __builtin_amdgcn_readfirstlane(F.tid >> 6); F.G = gridDim.x; F.bid = blockIdx.x;
    fill_frame(F, args.in, args.out, args.ws);

    for (int u = F.tid; u < (LDS_BYTES - MISC_OFF) / 4; u += 512) ((LAS unsigned*)(F.lds + MISC_OFF))[u] = 0u;
    __syncthreads();
    XcdBarrier bar; bar.bar = F.ctl + CW_BAR; bar.x = 0; bar.st = nullptr;
    if (!MK_SPLIT) bar = xcd_barrier_post(F.ctl + CW_BAR, (volatile LAS unsigned*)(F.lds + MISC_OFF));
    const int lo = args.ph_lo, hi = args.ph_hi;
#ifdef MK_ONLY
#define IN(k) ((k) == MK_ONLY)
#else
#define IN(k) (lo <= (k) && (k) < hi)
#endif
#define SEAM(k) do { if (IN(k) && IN((k) + 1)) { xcd_barrier(bar); if (MK_BAR_TWICE) xcd_barrier(bar); } } while (0)

#ifndef MK_REPEAT
#define MK_REPEAT (-1)
#endif
#define PHASE(k, ...) do { if (IN(k)) { __VA_ARGS__; if (MK_REPEAT == (k) && (k) != 6 && (k) != 9) { xcd_barrier(bar); __VA_ARGS__; } } SEAM(k); } while (0)
    PHASE(0, p0_prep(F));
    PHASE(1, { SchedP1 S{&F, D, D, F.G, F.bid, (const char*)F.xn, (const char*)F.mn, (const char*)F.WinT, (const char*)F.WmkvT};
               EpiP1 E{F.proj, F.kvraw, F.b_gate, F.gate8};
               pg8::gemm_phase<EpiP1, SchedP1>(F.lds, S, E);
               if (P1_FP8_TILES) { SchedP1b S8{&F, D / 2, D / 2, F.G, F.bid, (const char*)F.xn8, (const char*)F.Win8};
                   pg8::gemm_phase<EpiP1, SchedP1b>(F.lds, S8, E); } });
    PHASE(2, p2_prepass(F));
    PHASE(3, p3_attention(F));
    PHASE(4, { SchedP4 S{D, D, F.G, F.bid, (const char*)F.acat, (const char*)F.WcatT};
               EpiP4 E{F.proj, F.mscr, F.merged, F.gate8};
               SchedP4b S8{1536 / 2, 1536 / 2, F.G, F.bid, (const char*)F.acat8, (const char*)F.Wcat8};
               if (P4_FP8 && P4_SMALL_FIRST) pg8::gemm_phase<EpiP4, SchedP4b>(F.lds, S8, E);
               pg8::gemm_phase<EpiP4, SchedP4>(F.lds, S, E);
               if (P4_FP8 && !P4_SMALL_FIRST) pg8::gemm_phase<EpiP4, SchedP4b>(F.lds, S8, E); });
    PHASE(5, { SchedP5 S{D, D, F.G, F.bid, (const char*)F.merged, (const char*)F.WoutT};
               EpiP5 E{F.x, F.out, F.h1b};
               pg8::gemm_phase<EpiP5, SchedP5>(F.lds, S, E); });
    PHASE(6, p6_router(F));
    if (MK_REPEAT == 6) { xcd_barrier(bar); p6_router(F, true); }
    PHASE(7, { moe_tables(F);
               SchedP7 S{XN2_PREGATHER ? 64 : D * MOE_EB / 2, MOE_W_KTILE_MAJOR ? 64 : D * MOE_EB / 2, F.G, F.bid, *(const LAS int*)(F.lds + L_NMB), XN2_PREGATHER ? (const char*)F.xg : (const char*)F.xn2, (const char*)F.WupT, F.list, F.lds};
               EpiP7 E{F.b_up, F.act};
               pg8::gemm_phase<EpiP7, SchedP7>(F.lds, S, E); });
    PHASE(8, { if (!IN(7)) moe_tables(F);
               SchedP8 S{ACT_KTILE_MAJOR ? 64 : DFF * MOE_EB / 2, MOE_W_KTILE_MAJOR ? 64 : DFF * MOE_EB / 2, F.G, F.bid, *(const LAS int*)(F.lds + L_NMB), (const char*)F.act, (const char*)F.WdnT, F.lds};
               EpiP8 E{F.b_dn, F.ybuf};
               pg8::gemm_phase<EpiP8, SchedP8>(F.lds, S, E); });
    PHASE(9, { if (!IN(7)) moe_tables(F); p9_combine(F); });
    if (MK_REPEAT == 9) { xcd_barrier(bar); p9_combine(F, true); }
#undef PHASE
#undef IN
#undef SEAM
}

extern "C" void kernel_launch(void* const* d_in, const int* in_sizes, int n_in, void* d_out, int out_size, void* d_ws, size_t ws_size, hipStream_t stream) {
    static int grid = 0;
    if (grid == 0) {
        if (n_in != 26 || out_size != NTOK * D || ws_size < WS_END) { fprintf(stderr, "kernel_launch: unexpected problem shape (n_in %d, out %d, ws %zu < %zu)\n", n_in, out_size, ws_size, (size_t)WS_END); grid = -1; return; }
        int dev = 0, cus = 0, per_cu = 0;
        if (hipGetDevice(&dev) != hipSuccess || hipDeviceGetAttribute(&cus, hipDeviceAttributeMultiprocessorCount, dev) != hipSuccess) { grid = -1; return; }
        if (hipFuncSetAttribute((const void*)fwd, hipFuncAttributeMaxDynamicSharedMemorySize, LDS_BYTES) != hipSuccess) { fprintf(stderr, "kernel_launch: hipFuncSetAttribute failed\n"); grid = -1; return; }
        if (hipOccupancyMaxActiveBlocksPerMultiprocessor(&per_cu, (const void*)fwd, 512, LDS_BYTES) != hipSuccess || per_cu < 1) { fprintf(stderr, "kernel_launch: occupancy query says %d blocks per CU\n", per_cu); }
        (void)hipGetLastError();
        grid = cus;
    }
    if (grid < 0) return;
    (void)hipMemsetAsync((char*)d_ws + WS_CTL, 0, CTL_BYTES, stream);
    Args a{};
    for (int i = 0; i < 26; ++i) a.in[i] = d_in[i];
    a.out = (float*)d_out; a.ws = (unsigned char*)d_ws;
#if MK_SPLIT
    {
        const Frame F = host_frame(d_in, (float*)d_out, (unsigned char*)d_ws);
        float* a2 = (float*)((unsigned char*)d_ws + WS_ACT);
        if (MK_FAST) { a.ph_lo = 0; a.ph_hi = 1; hipLaunchKernelGGL(fwd, dim3(grid), dim3(512), LDS_BYTES, stream, a); }
        for (int p = 0; p < NPH; ++p) {
            if ((MK_FAST >> p) & 1) { if (p) { a.ph_lo = p; a.ph_hi = p + 1; hipLaunchKernelGGL(fwd, dim3(grid), dim3(512), LDS_BYTES, stream, a); } continue; }
#if MK_NAIVE
            switch (p) {
            case 0: hipLaunchKernelGGL(nv::k_rms, dim3(NTOK), dim3(256), 0, stream, F.x, F.g1, F.xn); hipLaunchKernelGGL(nv::k_rms, dim3(NMEMROW), dim3(256), 0, stream, F.mem, F.gmem, F.mn); break;
            case 1: { nv::PIn pi{F.xn, F.w_in, F.b_gate, F.proj, D}; hipLaunchKernelGGL(nv::k_gemm<nv::PIn>, dim3(IN_W / 64, NTOK / 64, 1), dim3(256), 0, stream, pi);
                      nv::PMkv pm{F.mn, F.w_mkv, F.kvraw, D}; hipLaunchKernelGGL(nv::k_gemm<nv::PMkv>, dim3(1024 / 64, NMEMROW / 64, 1), dim3(256), 0, stream, pm); } break;
            case 2: hipLaunchKernelGGL(nv::k_heads, dim3(NTOK * 14 / 256), dim3(256), 0, stream, F.proj, F.pos, F.gq, F.gk, F.gmq, F.qn, F.kn, F.mqn);
                    hipLaunchKernelGGL(nv::k_memk, dim3(NMEMROW * 4 / 256), dim3(256), 0, stream, F.kvraw, F.gmk, F.mk, F.mvT);
                    hipLaunchKernelGGL(nv::k_vT, dim3(NTOK), dim3(256), 0, stream, F.proj, F.vT);
                    hipLaunchKernelGGL(nv::k_pool, dim3(NTOK * 2), dim3(256), 0, stream, F.proj, F.acat); break;
            case 3: hipLaunchKernelGGL(nv::k_attn, dim3(NTOK * 3), dim3(256), 0, stream, F.qn, F.kn, F.vT, F.mqn, F.mk, F.mvT, F.sink, F.acat); break;
            case 4: { hipLaunchKernelGGL(nv::k_a2, dim3(NTOK * 2), dim3(256), 0, stream, F.acat, F.w_pg, F.pool_scale, a2);
                      nv::PBr b0{a2, nullptr, 512, 0, F.w_pp, F.proj, F.mscr, F.merged, 0, 512}; hipLaunchKernelGGL(nv::k_gemm<nv::PBr>, dim3(D / 64, NTOK / 64, 1), dim3(256), 0, stream, b0);
                      nv::PBr b1{nullptr, F.acat, D, 512, F.w_ap, F.proj, F.mscr, F.merged, 1, 1024}; hipLaunchKernelGGL(nv::k_gemm<nv::PBr>, dim3(D / 64, NTOK / 64, 1), dim3(256), 0, stream, b1);
                      nv::PBr b2{nullptr, F.acat, D, 1536, F.w_mp, F.proj, F.mscr, F.merged, 2, 512}; hipLaunchKernelGGL(nv::k_gemm<nv::PBr>, dim3(D / 64, NTOK / 64, 1), dim3(256), 0, stream, b2); } break;
            case 5: { nv::POut po{F.merged, F.w_out, F.x, F.out, D}; hipLaunchKernelGGL(nv::k_gemm<nv::POut>, dim3(D / 64, NTOK / 64, 1), dim3(256), 0, stream, po); } break;
            case 6: hipLaunchKernelGGL(nv::k_router, dim3(NTOK / 4), dim3(256), 0, stream, F.out, F.g2, F.w_r, F.b_r, F.xn2, F.ctl, F.list, F.er, F.tw); break;
            case 7: { nv::PUp pu{F.xn2, F.list, F.ctl, F.w_up, F.b_up, F.act, D}; hipLaunchKernelGGL(nv::k_gemm<nv::PUp>, dim3(2 * DFF / 64, NTOK / 64, NE), dim3(256), 0, stream, pu); } break;
            case 8: { nv::PDn pd{F.act, F.ctl, F.w_dn, F.b_dn, F.ybuf, DFF}; hipLaunchKernelGGL(nv::k_gemm<nv::PDn>, dim3(D / 64, NTOK / 64, NE), dim3(256), 0, stream, pd); } break;
            case 9: hipLaunchKernelGGL(nv::k_combine, dim3(NTOK), dim3(256), 0, stream, F.ctl, F.er, F.tw, F.ybuf, F.out); break;
            }
#endif
        }
    }
#else
    a.ph_lo = 0; a.ph_hi = NPH; hipLaunchKernelGGL(fwd, dim3(grid), dim3(512), LDS_BYTES, stream, a);
#endif
}
```

```cpp
#include <hip/hip_runtime.h>
#include <cstdio>
#include <cstdint>

#ifndef MK_SPLIT
#define MK_SPLIT 0
#endif

#define GAS __attribute__((address_space(1)))
#define LAS __attribute__((address_space(3)))
typedef unsigned short bf16_t;
typedef short bf16x8 __attribute__((ext_vector_type(8)));
typedef float f32x2 __attribute__((ext_vector_type(2)));
typedef float f32x4 __attribute__((ext_vector_type(4)));
typedef float f32x16 __attribute__((ext_vector_type(16)));
typedef unsigned u32x2 __attribute__((ext_vector_type(2)));
typedef unsigned u32x4 __attribute__((ext_vector_type(4)));
typedef __bf16 bf16x2v __attribute__((ext_vector_type(2)));
typedef int i32x4 __attribute__((ext_vector_type(4)));
typedef int i32x8 __attribute__((ext_vector_type(8)));

constexpr int D = 2048, NBATCH = 4, SEQ = 4096, NTOK = NBATCH * SEQ;
constexpr int IN_W = 8704, OFF_POOL = 0, OFF_Q = 512, OFF_K = 1536, OFF_V = 1792, OFF_MQ = 2048, OFF_GATE = 2560;
constexpr int MEMLEN = 256, NMEMROW = NBATCH * MEMLEN;
constexpr int NE = 32, DFF = 2048, CAP = NTOK, NSLOT = NTOK * 4 + NE * 256, MAXMB = NSLOT / 256;
constexpr float NORM_EPS = 1e-6f;
#ifndef MOE_FP8
#define MOE_FP8 1
#endif
constexpr int MOE_EB = MOE_FP8 ? 1 : 2;
constexpr float MOE_WSCALE = MOE_FP8 ? 64.0f : 1.0f;
#ifndef MK_BAR_TWICE
#ifndef PREFETCH_EARLY
#define PREFETCH_EARLY 1
#endif
#ifndef ACC_ZERO_IN_LOOP
#define ACC_ZERO_IN_LOOP 1
#endif
#define MK_BAR_TWICE 0
#endif
#ifndef MK_DMA_EXTRA
#define MK_DMA_EXTRA 0
#endif
#ifndef MK_LDS_EXTRA
#define MK_LDS_EXTRA 0
#endif
#ifndef MK_MFMA_TWICE
#define MK_MFMA_TWICE 0
#endif
#ifndef MK_EPI_TWICE
#define MK_EPI_TWICE 0
#endif
#ifndef MOE_PROBE
#define MOE_PROBE 0
#endif
#ifndef P1_FP8_TILES
#define P1_FP8_TILES 16
#endif
#ifndef GATE_BC_FP8
#define GATE_BC_FP8 1
#endif
#ifndef MOE_WGM
#define MOE_WGM 4
#endif
#ifndef MOE_WGM_DN
#define MOE_WGM_DN 8
#endif
#ifndef XN2_PREGATHER
#define XN2_PREGATHER 1
#endif
#ifndef ACT_KTILE_MAJOR
#define ACT_KTILE_MAJOR 1
#endif
#ifndef MOE_W_KTILE_MAJOR
#define MOE_W_KTILE_MAJOR 1
#endif
#ifndef P4_SMALL_FIRST
#define P4_SMALL_FIRST 1
#endif
#ifndef P4_SCR_BF16
#define P4_SCR_BF16 1
#endif
#ifndef H1_BF16
#define H1_BF16 1
#endif
#ifndef YBUF_FP8
#define YBUF_FP8 1
#endif
#ifndef P1_GATEA_FP8
#define P1_GATEA_FP8 1
#endif
#ifndef P1_QKV_FP8
#define P1_QKV_FP8 1
#endif
#ifndef P4_FP8
#define P4_FP8 1
#endif
#ifndef MOE_STAG_GROUPS
#define MOE_STAG_GROUPS 4
#define MOE_STAG_STEP 1
#endif
#ifndef MOE_CONV_IN_P1
#define MOE_CONV_IN_P1 1
#endif
constexpr float LOG2E = 1.4426950408889634f;
constexpr float QSCALE = 0.08838834764831845f * 1.4426950408889634f;

constexpr int P1_NF8 = P1_FP8_TILES + (P1_QKV_FP8 ? 8 : 0) + (P1_GATEA_FP8 ? 8 : 0), P1_NBF = 34 - P1_NF8;
__host__ __device__ constexpr int p1_tile_bf(int b) { return P1_GATEA_FP8 ? b : (P1_QKV_FP8 ? (b < 2 ? b : b + 8) : b); }
__host__ __device__ constexpr int p1_tile_f8(int f) { return P1_GATEA_FP8 ? f + 2 : (P1_QKV_FP8 ? (f < 8 ? f + 2 : f + 10) : 34 - P1_FP8_TILES + f); }
__host__ __device__ constexpr int p1_f8_index(int pn) { return P1_GATEA_FP8 ? pn - 2 : (P1_QKV_FP8 ? (pn < 10 ? pn - 2 : pn - 10) : pn - (34 - P1_FP8_TILES)); }
static_assert(!MOE_W_KTILE_MAJOR || MOE_FP8, "the k-tile-major weight layout is written for fp8 (128 k = 128 bytes)");
static_assert(!ACT_KTILE_MAJOR || MOE_FP8, "the k-tile-major activation layout is written for fp8");
constexpr size_t al256(size_t x) { return (x + 255) & ~(size_t)255; }
constexpr size_t WS_CTL = 0, CTL_BYTES = 1u << 20;
constexpr size_t WS_WIN_T = WS_CTL + CTL_BYTES;
constexpr size_t WS_WCAT_T = WS_WIN_T + (size_t)IN_W * D * 2;
constexpr size_t WS_WOUT_T = WS_WCAT_T + (size_t)D * D * 2;
constexpr size_t WS_WMKV_T = WS_WOUT_T + (size_t)D * D * 2;
constexpr size_t WS_WRF = WS_WMKV_T + (size_t)1024 * D * 2;
constexpr size_t WS_WUP_T = WS_WRF + (size_t)D * NE * 4;
constexpr size_t WS_WDN_T = WS_WUP_T + (size_t)NE * 2 * DFF * D * 2;
constexpr size_t WS_XN = WS_WDN_T + (size_t)NE * D * DFF * 2;
constexpr size_t WS_MN = WS_XN + (size_t)NTOK * D * 2;
constexpr size_t WS_PROJ = WS_MN + (size_t)NMEMROW * D * 2;
constexpr size_t WS_KVRAW = WS_PROJ + (size_t)NTOK * IN_W * 2;
constexpr size_t WS_QN = WS_KVRAW + (size_t)NMEMROW * 1024 * 2;
constexpr size_t WS_KN = WS_QN + (size_t)NTOK * 1024 * 2;
constexpr size_t WS_VT = WS_KN + (size_t)NTOK * 256 * 2;
constexpr size_t WS_MQN = WS_VT + (size_t)NTOK * 256 * 2;
constexpr size_t WS_MK = WS_MQN + (size_t)NTOK * 512 * 2;
constexpr size_t WS_MVT = WS_MK + (size_t)NMEMROW * 512 * 2;
constexpr size_t WS_ACAT = WS_MVT + (size_t)NMEMROW * 512 * 2;
constexpr size_t WS_MSCR = WS_ACAT + (size_t)NTOK * D * 2;
constexpr size_t WS_MERGED = WS_MSCR + (size_t)NTOK * D * 4;
constexpr size_t WS_XN2 = WS_MERGED + (size_t)NTOK * D * 2;
constexpr size_t WS_LIST = WS_XN2 + (size_t)NTOK * D * 2;
constexpr size_t WS_ER = WS_LIST + (size_t)NE * CAP * 4;
constexpr size_t WS_TW = WS_ER + (size_t)NTOK * 4 * 4;
constexpr size_t WS_ACT = WS_TW + (size_t)NTOK * 4 * 4;
constexpr size_t WS_YBUF = WS_ACT + (size_t)NSLOT * DFF * 2;
constexpr size_t WS_XN8 = WS_YBUF + (size_t)NSLOT * D * 2;
constexpr size_t WS_WIN8 = WS_XN8 + (size_t)NTOK * D;
constexpr size_t WS_ACAT8 = WS_WIN8 + (size_t)32 * 256 * D;
constexpr size_t WS_WCAT8 = WS_ACAT8 + (size_t)NTOK * 1536;
constexpr size_t WS_WRH = WS_WCAT8 + (size_t)D * 1536;
constexpr size_t WS_WRL = WS_WRH + (size_t)NE * D * 2;
constexpr size_t WS_H1B = WS_WRL + (size_t)NE * D * 2;
constexpr size_t WS_GATE8 = WS_H1B + (size_t)NTOK * D * 2;
constexpr size_t WS_XG = WS_GATE8 + (size_t)NTOK * 2 * D;
constexpr size_t WS_END = WS_XG + (XN2_PREGATHER ? (size_t)NE * 16 * CAP * 128 : 0);
constexpr int CW_BAR = 4096;
constexpr int CW_CNT = 16384;

constexpr int RING_BYTES = 131072, MISC_OFF = 133120  , LDS_BYTES = MISC_OFF + 8192 + (MK_DMA_EXTRA ? 8192 : 0);
constexpr int L_CNT = MISC_OFF + 64, L_MBST = MISC_OFF + 256, L_NMB = MISC_OFF + 448, L_MBE = MISC_OFF + 512, L_MBR0 = MISC_OFF + 2048;

__device__ __forceinline__ unsigned pk2(float lo, float hi) { f32x2 v = {lo, hi}; return __builtin_bit_cast(unsigned, __builtin_convertvector(v, bf16x2v)); }
__device__ __forceinline__ float bflo(unsigned w) { return __uint_as_float(w << 16); }
__device__ __forceinline__ float bfhi(unsigned w) { return __uint_as_float(w & 0xffff0000u); }
__device__ __forceinline__ float bf2f(bf16_t b) { return __uint_as_float((unsigned)b << 16); }
__device__ __forceinline__ bf16_t f2bf(float f) { return (bf16_t)(pk2(f, 0.f) & 0xffffu); }
__device__ __forceinline__ float wave_sum(float v) {
#pragma unroll
    for (int o = 1; o < 64; o <<= 1) v += __shfl_xor(v, o);
    return v;
}
__device__ __forceinline__ float fast_sigmoid(float x) { return __builtin_amdgcn_rcpf(1.0f + __builtin_amdgcn_exp2f(-LOG2E * x)); }
#define LDS_WAIT() asm volatile("s_waitcnt lgkmcnt(0)" ::: "memory")

#define XB_TMO      128
#define XB_XCNT(j)  (256  + 64 * (j))
#define XB_XSUB(j)  (1280 + 64 * (j))
#define XB_XGEN(j)  (2304 + 64 * (j))
#define XB_TOP      3328
#define XB_TOPGEN   3392
#define XCD_BAR_WORDS 3456
#define XB_SPIN_CAP (1u << 18)
__device__ __forceinline__ unsigned xb_ld(unsigned* p)              { return __hip_atomic_load(p, __ATOMIC_RELAXED, __HIP_MEMORY_SCOPE_AGENT); }
__device__ __forceinline__ unsigned xb_add(unsigned* p, unsigned v) { return __hip_atomic_fetch_add(p, v, __ATOMIC_RELAXED, __HIP_MEMORY_SCOPE_AGENT); }
__device__ __forceinline__ unsigned xb_xcc_id() { return (unsigned)__builtin_amdgcn_s_getreg((3 << 11) | 20) & 0xFu; }
#define XB_SPIN(cond, bar) do { unsigned _sp = 0; while (cond) { __builtin_amdgcn_s_sleep(1); \
    if ((++_sp & 255u) == 0u) { if (xb_ld(&(bar)[XB_TMO])) break; if (_sp > XB_SPIN_CAP) { atomicAdd(&(bar)[XB_TMO], 1u); break; } } } } while (0)
struct XcdBarrier { unsigned* bar; unsigned x; volatile LAS unsigned* st; };
__device__ __forceinline__ XcdBarrier xcd_barrier_post(unsigned* bar, volatile LAS unsigned* st) {
    XcdBarrier b; b.bar = bar; b.x = xb_xcc_id(); b.st = st;
    if (threadIdx.x == 0) (void)xb_add(&bar[XB_XCNT(b.x)], 1u);
    return b;
}
__device__ __forceinline__ void xcd_barrier_complete(unsigned* bar, unsigned x, unsigned& nloc, unsigned& nx) {
    const unsigned G = gridDim.x * gridDim.y * gridDim.z;
    unsigned sum, cnt, mine, sp = 0u;
    for (;;) {
        sum = 0u; cnt = 0u; mine = 0u;
#pragma unroll
        for (unsigned j = 0; j < 16; ++j) { const unsigned c = xb_ld(&bar[XB_XCNT(j)]); sum += c; cnt += (c > 0u) ? 1u : 0u; mine = (j == x) ? c : mine; }
        if (sum == G) break;
        __builtin_amdgcn_s_sleep(1);
        if ((++sp & 255u) == 0u) { if (xb_ld(&bar[XB_TMO])) break; if (sp > XB_SPIN_CAP) { atomicAdd(&bar[XB_TMO], 1u); break; } }
    }
    nloc = mine > 0u ? mine : 1u; nx = cnt > 0u ? cnt : 1u;
}
__device__ __forceinline__ void xcd_barrier(const XcdBarrier& b) {
    asm volatile("s_waitcnt vmcnt(0)" ::: "memory");
    __syncthreads();
    if (threadIdx.x == 0) {
        unsigned* bar = b.bar;
        __builtin_amdgcn_s_waitcnt(0);
        unsigned nloc = b.st[0], nx = b.st[1];
        if (nloc == 0u) { xcd_barrier_complete(bar, b.x, nloc, nx); b.st[0] = nloc; b.st[1] = nx; }
        const unsigned old = xb_add(&bar[XB_XSUB(b.x)], 1u);
        const unsigned gen = old / nloc;
        if (old + 1u == (gen + 1u) * nloc) {
            __builtin_amdgcn_fence(__ATOMIC_RELEASE, "agent");
            asm volatile("s_waitcnt vmcnt(0)" ::: "memory");
            const unsigned og = xb_add(&bar[XB_TOP], 1u);
            const unsigned tg = og / nx;
            if (og + 1u == (tg + 1u) * nx) xb_add(&bar[XB_TOPGEN], 1u);
            else XB_SPIN(xb_ld(&bar[XB_TOPGEN]) == tg, bar);
            __builtin_amdgcn_fence(__ATOMIC_ACQUIRE, "agent");
            xb_add(&bar[XB_XGEN(b.x)], 1u);
            asm volatile("s_waitcnt vmcnt(0)" ::: "memory");
        } else {
            XB_SPIN(xb_ld(&bar[XB_XGEN(b.x)]) == gen, bar);
            __builtin_amdgcn_fence(__ATOMIC_ACQUIRE, "agent");
            asm volatile("s_waitcnt vmcnt(0)" ::: "memory");
        }
    }
    __syncthreads();
}

namespace pg8 {
constexpr int BM = 256, BK = 64, HALF = 128, HTB = HALF * BK * 2, STAGE_BYTES = 8 * HTB, NXCD = 8, WGM = 4;
__device__ __forceinline__ int lds_byte(int r, int c) { const int st = (r >> 4) * 2 + (c >> 5), rr = r & 15, cc = c & 31, ob = rr * 64 + cc * 2; return st * 1024 + (ob ^ (((ob >> 9) & 1) << 5)); }
__device__ __forceinline__ void stage_rc(int b, int& R, int& C) { const int st = b / 1024, sb = b % 1024, swz = sb ^ (((sb >> 9) & 1) << 5); R = (st >> 1) * 16 + swz / 64; C = (st & 1) * 32 + (swz % 64) / 2; }
struct Unit { int pm, pn, aux; };
__device__ __forceinline__ void mfma_fp8(f32x4& c, const i32x8 a, const i32x8 b, int sa, int sb) {
    asm volatile("v_mfma_scale_f32_16x16x128_f8f6f4 %0, %1, %2, %0, %3, %4 op_sel_hi:[0,0,0]" : "+v"(c) : "v"(a), "v"(b), "v"(sa), "v"(sb));
}
__device__ __forceinline__ void mfma_fp8_settle() { asm volatile("s_nop 7\n\ts_nop 7\n\ts_nop 7" ::: "memory"); }
__device__ __forceinline__ void tile_of(int L, int nM, int nN, int& pm, int& pn, const int WGM = pg8::WGM) {
    const int nwg = nM * nN; int wgid = L;
    { const int q = nwg / NXCD, r = nwg % NXCD, xcd = wgid % NXCD, off = wgid / NXCD; wgid = (xcd < r ? xcd * (q + 1) : r * (q + 1) + (xcd - r) * q) + off; }
    const int nig = WGM * nN, gid = wgid / nig, fm = gid * WGM, gsz = (nM - fm) < WGM ? (nM - fm) : WGM;
    pm = fm + ((wgid % nig) % gsz); pn = (wgid % nig) / gsz;
}
template <int MODE> __device__ __forceinline__ int brow(int R) { return MODE == 0 ? R : 64 * (R >> 5) + 16 * ((R & 15) >> 2) + 4 * ((R >> 4) & 1) + (R & 3); }

template <class Epi, class Sched>
__device__ __forceinline__ void gemm_phase(LAS unsigned char* lds, const Sched& S, const Epi& E) {
    const int tid = threadIdx.x, wid = __builtin_amdgcn_readfirstlane(tid >> 6), lane = tid & 63, wr = wid >> 2, wc = wid & 3, fr = lane & 15, fq = lane >> 4;
    unsigned voffA[2], voffA1[2], voffB[2]; int gR[2], gC[2];
#pragma unroll
    for (int i = 0; i < 2; ++i) { int R, C; stage_rc(tid * 16 + i * 8192, R, C);
        voffB[i] = (unsigned)(brow<Epi::MODE>(R) * S.ldb + C) * 2u; voffA[i] = (unsigned)(R * S.lda + C) * 2u; voffA1[i] = voffA[i]; gR[i] = R; gC[i] = C * 2; }
    const size_t kstepB = S.kstep_b(), kstep = S.kstep_a();
    const size_t hstepA = (size_t)HALF * S.lda * 2;
    const size_t hstepB = (size_t)(Epi::MODE == 0 ? HALF : 8) * S.ldb * 2;
    const unsigned ldsw = (unsigned)wid * 1024u;
    const int aoff = lds_byte(wr * 64 + fr, fq * 8), boff = lds_byte(wc * 32 + fr, fq * 8);
#define PG8_SA(b, h) (((b) * 2 + (h)) * HTB)
#define PG8_SB(b, h) ((4 + (b) * 2 + (h)) * HTB)
#define PG8_STAGE(bufoff, gbase, voff) do { _Pragma("unroll") for (int _i = 0; _i < 2; ++_i) { unsigned _vo = (voff)[_i]; asm volatile("" : "+v"(_vo)); \
        __builtin_amdgcn_global_load_lds((const unsigned*)((const char*)(gbase) + _vo), (LAS unsigned*)(lds + (bufoff) + ldsw + _i * 8192), 16, 0, 0); } } while (0)
#define PG8_STAGE_A0(bufoff, gbase) PG8_STAGE(bufoff, gbase, voffA)
#define PG8_STAGE_A1(bufoff, gbase) do { if constexpr (Sched::GATHER) { PG8_STAGE(bufoff, gbase, voffA1); } else { PG8_STAGE(bufoff, (gbase) + hstepA, voffA); } } while (0)
#define PG8_LDA(dst, b, h) do { _Pragma("unroll") for (int m = 0; m < 4; ++m) _Pragma("unroll") for (int k = 0; k < 2; ++k) dst[m][k] = *(const LAS bf16x8*)(lds + PG8_SA(b, h) + aoff + m * 2048 + k * 1024); } while (0)
#define PG8_LDB(dst, b, h) do { _Pragma("unroll") for (int n = 0; n < 2; ++n) _Pragma("unroll") for (int k = 0; k < 2; ++k) dst[n][k] = *(const LAS bf16x8*)(lds + PG8_SB(b, h) + boff + n * 2048 + k * 1024); } while (0)
#define PG8_CAT8(x) __builtin_shufflevector(__builtin_bit_cast(i32x4, (x)[0]), __builtin_bit_cast(i32x4, (x)[1]), 0, 1, 2, 3, 4, 5, 6, 7)
#define PG8_MMA(ai, bj, At, Bt) do { __builtin_amdgcn_s_setprio(1); \
        if constexpr (Sched::FP8) { _Pragma("unroll") for (int m = 0; m < 4; ++m) _Pragma("unroll") for (int n = 0; n < 2; ++n) \
            { mfma_fp8(acc[ai][bj][m][n], PG8_CAT8(Bt[n]), PG8_CAT8(At[m]), Sched::SCALE_B, 0x7f7f7f7f); if (MK_MFMA_TWICE) mfma_fp8(dummy_acc[(m * 2 + n) & 3], PG8_CAT8(Bt[n]), PG8_CAT8(At[m]), Sched::SCALE_B, 0x7f7f7f7f); } } \
        else { _Pragma("unroll") for (int m = 0; m < 4; ++m) _Pragma("unroll") for (int n = 0; n < 2; ++n) _Pragma("unroll") for (int k = 0; k < 2; ++k) \
            acc[ai][bj][m][n] = __builtin_amdgcn_mfma_f32_16x16x32_bf16(Bt[n][k], At[m][k], acc[ai][bj][m][n], 0, 0, 0); } \
        __builtin_amdgcn_s_setprio(0); } while (0)
#define PG8_LDX(b, h) do { if constexpr (Sched::FP8 && MK_LDS_EXTRA) { _Pragma("unroll") for (int m = 0; m < 4; ++m) _Pragma("unroll") for (int k = 0; k < 2; ++k) { bf16x8 _d = *(const LAS bf16x8*)(lds + PG8_SA(b, h) + aoff + m * 2048 + k * 1024 + 4096); asm volatile("" :: "v"(_d)); } } } while (0)
#define PG8_DMX(gbase) do { if constexpr (Sched::FP8 && MK_DMA_EXTRA) { unsigned _vo = voffB[0]; asm volatile("" : "+v"(_vo)); \
        __builtin_amdgcn_global_load_lds((const unsigned*)((const char*)(gbase) + _vo), (LAS unsigned*)(lds + MISC_OFF + 8192 + ldsw), 16, 0, 0); } } while (0)
#define PG8_WAIT_V8() do { if constexpr (Sched::FP8 && MK_DMA_EXTRA) asm volatile("s_waitcnt vmcnt(10)" ::: "memory"); else asm volatile("s_waitcnt vmcnt(8)" ::: "memory"); } while (0)
#define PG8_WAIT_V(n) asm volatile("s_waitcnt vmcnt(" #n ")" ::: "memory")
#define PG8_WAIT_L(n) asm volatile("s_waitcnt lgkmcnt(" #n ")" ::: "memory")
#define PG8_BAR __builtin_amdgcn_s_barrier()
#define PG8_SCHED __builtin_amdgcn_sched_barrier(0)
    Unit cur, nxt; int ui = 0; bool side_done = false;
    constexpr bool PRE_EARLY = PREFETCH_EARLY && sizeof(typename Epi::Pre) == 64;
    constexpr bool ZIL = ACC_ZERO_IN_LOOP && sizeof(typename Epi::Pre) <= 64;
    if constexpr (Sched::SIDE_FIRST) { S.side(); if (!S.next(0, cur)) return; }
    else { if (!S.next(0, cur)) { S.side(); return; } }
    f32x4 acc[2][2][4][2];
#pragma unroll
    for (int a = 0; a < 2; ++a)
#pragma unroll
        for (int b = 0; b < 2; ++b)
#pragma unroll
            for (int m = 0; m < 4; ++m)
#pragma unroll
                for (int n = 0; n < 2; ++n) acc[a][b][m][n] = (f32x4){0.f, 0.f, 0.f, 0.f};
    bf16x8 At[4][2], B0[2][2], B1[2][2];
    f32x4 dummy_acc[4] = {{0.f, 0.f, 0.f, 0.f}, {0.f, 0.f, 0.f, 0.f}, {0.f, 0.f, 0.f, 0.f}, {0.f, 0.f, 0.f, 0.f}};
    const char* cA = S.a_base(cur); const char* cB = S.b_base(cur); int cnt = S.nt(cur);
    if constexpr (Sched::GATHER) {
#pragma unroll
        for (int i = 0; i < 2; ++i) { voffA[i] = S.gather(cur, gR[i], gC[i]); voffA1[i] = S.gather(cur, gR[i] + HALF, gC[i]); }
    }
    PG8_STAGE(PG8_SB(0, 0), cB, voffB); PG8_STAGE(PG8_SB(0, 1), cB + hstepB, voffB); PG8_STAGE_A0(PG8_SA(0, 0), cA); PG8_STAGE_A1(PG8_SA(0, 1), cA);
    if (wr == 1) PG8_BAR;
    PG8_WAIT_V(2); PG8_BAR;
    PG8_STAGE(PG8_SB(1, 0), cB + kstepB, voffB); PG8_STAGE_A0(PG8_SA(1, 0), cA + kstep); PG8_STAGE(PG8_SB(1, 1), cB + hstepB + kstepB, voffB);
    PG8_WAIT_V(6); PG8_BAR;
    [[maybe_unused]] typename Epi::Pre pre_nx; if constexpr (PRE_EARLY) pre_nx = E.prefetch(cur, wc, (int)__builtin_amdgcn_mbcnt_hi(~0u, __builtin_amdgcn_mbcnt_lo(~0u, 0u)) >> 4);
    for (;;) {
        const bool has_next = S.next(ui + 1, nxt);
        typename Epi::Pre pre; if constexpr (PRE_EARLY) pre = pre_nx; else pre = E.prefetch(cur, wc, (int)__builtin_amdgcn_mbcnt_hi(~0u, __builtin_amdgcn_mbcnt_lo(~0u, 0u)) >> 4);
        const char* nA = has_next ? S.a_base(nxt) : cA; const char* nB = has_next ? S.b_base(nxt) : cB;
        const int nt = cnt;
        unsigned gx0[2] = {voffA[0], voffA[1]}, gx1[2] = {voffA1[0], voffA1[1]};
        if constexpr (Sched::GATHER) { if (has_next) {
#pragma unroll
            for (int i = 0; i < 2; ++i) { gx0[i] = S.gather(nxt, gR[i], gC[i]); gx1[i] = S.gather(nxt, gR[i] + HALF, gC[i]); } } }
        for (int t = 0; t < nt; t += 2) {
            const bool last = (t == nt - 2);
            const char* a1 = cA + (size_t)(t + 1) * kstep;
            const char* a2 = last ? nA : cA + (size_t)(t + 2) * kstep; const char* b2 = last ? nB : cB + (size_t)(t + 2) * kstepB;
            const char* a3 = a2 + kstep; const char* b3 = b2 + kstepB;
            unsigned nv0[2] = {voffA[0], voffA[1]}, nv1[2] = {voffA1[0], voffA1[1]};
            if constexpr (Sched::GATHER) { if (last && has_next) { nv0[0] = gx0[0]; nv0[1] = gx0[1]; nv1[0] = gx1[0]; nv1[1] = gx1[1]; } }
            PG8_LDB(B0, 0, 0); PG8_LDB(B1, 0, 1); PG8_SCHED; PG8_LDA(At, 0, 0); PG8_LDX(0, 0); PG8_STAGE_A1(PG8_SA(1, 1), a1);
            if constexpr (ZIL) { PG8_SCHED;
                if (t == 0) {
#pragma unroll
                        for (int b = 0; b < 2; ++b)
#pragma unroll
                            for (int m = 0; m < 4; ++m)
#pragma unroll
                                for (int n = 0; n < 2; ++n) acc[0][b][m][n] = (f32x4){0.f, 0.f, 0.f, 0.f}; }
                PG8_SCHED; }
            if constexpr (Sched::GATHER) { voffA[0] = nv0[0]; voffA[1] = nv0[1]; voffA1[0] = nv1[0]; voffA1[1] = nv1[1]; }
            PG8_DMX(cB); PG8_WAIT_V8(); PG8_WAIT_L(0); PG8_BAR; PG8_MMA(0, 0, At, B0); PG8_MMA(0, 1, At, B1); PG8_BAR; PG8_SCHED;
            PG8_LDA(At, 0, 1); PG8_LDX(0, 1); PG8_STAGE(PG8_SB(0, 0), b2, voffB); PG8_STAGE(PG8_SB(0, 1), b2 + hstepB, voffB); PG8_STAGE_A0(PG8_SA(0, 0), a2);
            if constexpr (ZIL) { PG8_SCHED;
                if (t == 0) {
#pragma unroll
                        for (int b = 0; b < 2; ++b)
#pragma unroll
                            for (int m = 0; m < 4; ++m)
#pragma unroll
                                for (int n = 0; n < 2; ++n) acc[1][b][m][n] = (f32x4){0.f, 0.f, 0.f, 0.f}; }
                PG8_SCHED; }
            PG8_DMX(cB); PG8_WAIT_V8(); PG8_WAIT_L(0); PG8_BAR; PG8_MMA(1, 0, At, B0); PG8_MMA(1, 1, At, B1); PG8_BAR; PG8_SCHED;
            PG8_LDB(B0, 1, 0); PG8_LDB(B1, 1, 1); PG8_SCHED; PG8_LDA(At, 1, 0); PG8_LDX(1, 0); PG8_STAGE_A1(PG8_SA(0, 1), a2);
            PG8_DMX(cB); PG8_WAIT_V8(); PG8_WAIT_L(0); PG8_BAR; PG8_MMA(0, 0, At, B0); PG8_MMA(0, 1, At, B1); PG8_BAR; PG8_SCHED;
            PG8_LDA(At, 1, 1); PG8_LDX(1, 1); PG8_STAGE(PG8_SB(1, 0), b3, voffB); PG8_STAGE(PG8_SB(1, 1), b3 + hstepB, voffB); PG8_STAGE_A0(PG8_SA(1, 0), a3);
            PG8_DMX(cB); PG8_WAIT_V8(); PG8_WAIT_L(0); PG8_BAR; PG8_MMA(1, 0, At, B0); PG8_MMA(1, 1, At, B1); PG8_BAR; PG8_SCHED;
        }
        if (wr == 0) PG8_BAR;
        if constexpr (Sched::FP8) mfma_fp8_settle();
        { const int l2 = (int)__builtin_amdgcn_mbcnt_hi(~0u, __builtin_amdgcn_mbcnt_lo(~0u, 0u));
          if constexpr (PRE_EARLY) { if (has_next) pre_nx = E.prefetch(nxt, wc, l2 >> 4); }
          E(acc, cur, wr, wc, l2 & 15, l2 >> 4, pre);
          if constexpr (Epi::PROBE_TWICE) { asm volatile("s_waitcnt vmcnt(0)" ::: "memory"); E(acc, cur, wr, wc, l2 & 15, l2 >> 4, pre); } }
        if constexpr (!Sched::SIDE_FIRST) { if (!side_done && (!has_next || S.side_due(ui))) { S.side(); side_done = true; } }
        if (!has_next) break;
        if constexpr (!ZIL) {
#pragma unroll
        for (int a = 0; a < 2; ++a)
#pragma unroll
            for (int b = 0; b < 2; ++b)
#pragma unroll
                for (int m = 0; m < 4; ++m)
#pragma unroll
                    for (int n = 0; n < 2; ++n) acc[a][b][m][n] = (f32x4){0.f, 0.f, 0.f, 0.f}; }
        cur = nxt; cA = nA; cB = nB; cnt = S.nt(nxt); ++ui;
        if (wr == 1) PG8_BAR;
    }
    PG8_WAIT_V(0);
    PG8_BAR;
    if (MK_MFMA_TWICE) { _Pragma("unroll") for (int q = 0; q < 4; ++q) asm volatile("" :: "v"(dummy_acc[q])); }
#undef PG8_SA
#undef PG8_SB
#undef PG8_STAGE
#undef PG8_STAGE_A0
#undef PG8_STAGE_A1
#undef PG8_LDA
#undef PG8_LDB
#undef PG8_MMA
#undef PG8_CAT8
#undef PG8_WAIT_V
#undef PG8_WAIT_V8
#undef PG8_DMX
#undef PG8_LDX
#undef PG8_WAIT_L
#undef PG8_BAR
#undef PG8_SCHED
}
}
using pg8::Unit;

struct Args { const void* in[26]; float* out; unsigned char* ws; int ph_lo, ph_hi; };
struct Frame {
    LAS unsigned char* lds; int tid, lane, wave, G, bid;
    const float *x, *mem; const int* pos; const float *g1, *w_in, *b_gate, *w_pg, *pool_scale, *w_pp, *gq, *gk, *sink, *w_ap, *gmem, *w_mkv, *gmq, *gmk, *w_mp, *w_out, *g2, *w_r, *b_r, *w_up, *b_up, *w_dn, *b_dn;
    float* out; unsigned char* ws; unsigned* ctl;
    bf16_t *WinT, *WcatT, *WoutT, *WmkvT, *WupT, *WdnT, *xn, *mn, *proj, *kvraw, *qn, *kn, *vT, *mqn, *mk, *mvT, *acat, *merged, *xn2, *act, *ybuf;
    float *wrf, *mscr, *tw; int* list; unsigned* er; unsigned char *xn8, *Win8, *acat8, *Wcat8; bf16_t *wrh, *wrl, *h1b; unsigned char *gate8, *xg;
};

__host__ __device__ __forceinline__ void fill_frame(Frame& F, const void* const* in, float* out, unsigned char* ws) {
    F.x = (const float*)in[0]; F.mem = (const float*)in[1]; F.pos = (const int*)in[2]; F.g1 = (const float*)in[3]; F.w_in = (const float*)in[4]; F.b_gate = (const float*)in[5];
    F.w_pg = (const float*)in[6]; F.pool_scale = (const float*)in[7]; F.w_pp = (const float*)in[8]; F.gq = (const float*)in[9]; F.gk = (const float*)in[10]; F.sink = (const float*)in[11];
    F.w_ap = (const float*)in[12]; F.gmem = (const float*)in[13]; F.w_mkv = (const float*)in[14]; F.gmq = (const float*)in[15]; F.gmk = (const float*)in[16]; F.w_mp = (const float*)in[17];
    F.w_out = (const float*)in[18]; F.g2 = (const float*)in[19]; F.w_r = (const float*)in[20]; F.b_r = (const float*)in[21]; F.w_up = (const float*)in[22]; F.b_up = (const float*)in[23];
    F.w_dn = (const float*)in[24]; F.b_dn = (const float*)in[25];
    F.out = out; F.ws = ws; F.ctl = (unsigned*)(ws + WS_CTL);
    F.WinT = (bf16_t*)(ws + WS_WIN_T); F.WcatT = (bf16_t*)(ws + WS_WCAT_T); F.WoutT = (bf16_t*)(ws + WS_WOUT_T); F.WmkvT = (bf16_t*)(ws + WS_WMKV_T); F.wrf = (float*)(ws + WS_WRF);
    F.WupT = (bf16_t*)(ws + WS_WUP_T); F.WdnT = (bf16_t*)(ws + WS_WDN_T); F.xn = (bf16_t*)(ws + WS_XN); F.mn = (bf16_t*)(ws + WS_MN); F.proj = (bf16_t*)(ws + WS_PROJ); F.kvraw = (bf16_t*)(ws + WS_KVRAW);
    F.qn = (bf16_t*)(ws + WS_QN); F.kn = (bf16_t*)(ws + WS_KN); F.vT = (bf16_t*)(ws + WS_VT); F.mqn = (bf16_t*)(ws + WS_MQN); F.mk = (bf16_t*)(ws + WS_MK); F.mvT = (bf16_t*)(ws + WS_MVT);
    F.acat = (bf16_t*)(ws + WS_ACAT); F.mscr = (float*)(ws + WS_MSCR); F.merged = (bf16_t*)(ws + WS_MERGED); F.xn2 = (bf16_t*)(ws + WS_XN2); F.list = (int*)(ws + WS_LIST); F.er = (unsigned*)(ws + WS_ER);
    F.tw = (float*)(ws + WS_TW); F.act = (bf16_t*)(ws + WS_ACT); F.ybuf = (bf16_t*)(ws + WS_YBUF); F.xn8 = ws + WS_XN8; F.Win8 = ws + WS_WIN8; F.acat8 = ws + WS_ACAT8; F.Wcat8 = ws + WS_WCAT8; F.wrh = (bf16_t*)(ws + WS_WRH); F.wrl = (bf16_t*)(ws + WS_WRL); F.h1b = (bf16_t*)(ws + WS_H1B); F.gate8 = ws + WS_GATE8; F.xg = ws + WS_XG;
}
static Frame host_frame(void* const* d_in, float* out, unsigned char* ws) { Frame F{}; fill_frame(F, (const void* const*)d_in, out, ws); return F; }

__device__ __forceinline__ void tr_load(const float* W, int N, int kb, int nb, int lane, f32x4 (&v)[16]) {
    const float* p = W + (size_t)(64 * kb + 16 * (lane >> 4)) * N + 64 * nb + 4 * (lane & 15);
#pragma unroll
    for (int i = 0; i < 16; ++i) v[i] = __builtin_nontemporal_load((const f32x4*)(p + (size_t)i * N));
}
template <bool FP8>
__device__ __forceinline__ void tr_store(const f32x4 (&v)[16], unsigned char* WT, size_t ldt_bytes, int koff, int kb, int nb, float scale, int lane) {
    const int kq = lane >> 4, nq = lane & 15;
#pragma unroll
    for (int j = 0; j < 4; ++j) {
        unsigned char* row = WT + (size_t)(64 * nb + 4 * nq + j) * ldt_bytes;
        if (FP8) { u32x4 o; unsigned w;
            w = __builtin_amdgcn_cvt_pk_fp8_f32(v[0][j] * scale, v[1][j] * scale, 0u, false); o.x = __builtin_amdgcn_cvt_pk_fp8_f32(v[2][j] * scale, v[3][j] * scale, w, true);
            w = __builtin_amdgcn_cvt_pk_fp8_f32(v[4][j] * scale, v[5][j] * scale, 0u, false); o.y = __builtin_amdgcn_cvt_pk_fp8_f32(v[6][j] * scale, v[7][j] * scale, w, true);
            w = __builtin_amdgcn_cvt_pk_fp8_f32(v[8][j] * scale, v[9][j] * scale, 0u, false); o.z = __builtin_amdgcn_cvt_pk_fp8_f32(v[10][j] * scale, v[11][j] * scale, w, true);
            w = __builtin_amdgcn_cvt_pk_fp8_f32(v[12][j] * scale, v[13][j] * scale, 0u, false); o.w = __builtin_amdgcn_cvt_pk_fp8_f32(v[14][j] * scale, v[15][j] * scale, w, true);
            *(u32x4*)(row + (size_t)(koff + 64 * kb + 16 * kq)) = o;
        } else { u32x4 o0, o1;
            o0.x = pk2(v[0][j], v[1][j]); o0.y = pk2(v[2][j], v[3][j]); o0.z = pk2(v[4][j], v[5][j]); o0.w = pk2(v[6][j], v[7][j]);
            o1.x = pk2(v[8][j], v[9][j]); o1.y = pk2(v[10][j], v[11][j]); o1.z = pk2(v[12][j], v[13][j]); o1.w = pk2(v[14][j], v[15][j]);
            u32x4* dst = (u32x4*)(row + (size_t)(koff + 64 * kb + 16 * kq) * 2); dst[0] = o0; dst[1] = o1; }
    }
}
__device__ __forceinline__ void p0_transpose_item(const float* W, int N, int K, bf16_t* WT, int ldt, int koff, int item, int lane) {
    const int nkb = K / 64, kb = item % nkb, nb = item / nkb; f32x4 v[16];
    tr_load(W, N, kb, nb, lane, v); tr_store<false>(v, (unsigned char*)WT, (size_t)ldt * 2, koff, kb, nb, 1.0f, lane);
}
struct MoeItem { const float* W; unsigned char* WT; int N; };
constexpr int MOE_ITEMS = NE * (16 * 128 + 16 * 64);
__device__ __forceinline__ MoeItem moe_item(const Frame& F, int it, const bool alt = false) {
    constexpr int I_UP1 = 16 * 128, I_UP = NE * I_UP1, I_DN1 = 16 * 64; MoeItem m;
    if (it < I_UP) { const int e = it / I_UP1, r = it % I_UP1, kb = r >> 7, nb = r & 127; m.N = 2 * DFF;
        m.W = alt ? F.w_up + ((size_t)e * D + 16 * (r >> 4)) * (2 * DFF) + 256 * (r & 15) : F.w_up + ((size_t)e * D + 128 * kb) * (2 * DFF) + 32 * nb; m.WT = MOE_W_KTILE_MAJOR ? (unsigned char*)F.WupT + (size_t)e * 2 * DFF * D + ((size_t)kb * 2 * DFF + 32 * nb) * 128 : (unsigned char*)F.WupT + (((size_t)e * 2 * DFF + 32 * nb) * D + 128 * kb) * MOE_EB; }
    else { const int i2 = it - I_UP, e = i2 / I_DN1, r = i2 % I_DN1, kb = r >> 6, nb = r & 63; m.N = D;
        m.W = alt ? F.w_dn + ((size_t)e * DFF + 16 * (r >> 3)) * D + 256 * (r & 7) : F.w_dn + ((size_t)e * DFF + 128 * kb) * D + 32 * nb; m.WT = MOE_W_KTILE_MAJOR ? (unsigned char*)F.WdnT + (size_t)e * D * DFF + ((size_t)kb * D + 32 * nb) * 128 : (unsigned char*)F.WdnT + (((size_t)e * D + 32 * nb) * DFF + 128 * kb) * MOE_EB; }
    return m;
}
__device__ __forceinline__ void moe_load(const MoeItem& m, int lane, f32x4 (&v)[16], const bool alt = false) {
    const float* p = alt ? m.W + 4 * lane : m.W + (size_t)(16 * (lane >> 3)) * m.N + 4 * (lane & 7);
#pragma unroll
    for (int i = 0; i < 16; ++i) v[i] = __builtin_nontemporal_load((const f32x4*)(p + (size_t)i * m.N));
}
__device__ __forceinline__ void moe_store(const MoeItem& m, int lane, const f32x4 (&v)[16]) {
#pragma unroll
    for (int j = 0; j < 4; ++j) {
        unsigned char* dst = m.WT + ((size_t)(4 * (lane & 7) + j) * (MOE_W_KTILE_MAJOR ? 128 : 2048) + 16 * (lane >> 3)) * MOE_EB;
        if (MOE_FP8) { u32x4 o; unsigned w;
            w = __builtin_amdgcn_cvt_pk_fp8_f32(v[0][j] * MOE_WSCALE, v[1][j] * MOE_WSCALE, 0u, false); o.x = __builtin_amdgcn_cvt_pk_fp8_f32(v[2][j] * MOE_WSCALE, v[3][j] * MOE_WSCALE, w, true);
            w = __builtin_amdgcn_cvt_pk_fp8_f32(v[4][j] * MOE_WSCALE, v[5][j] * MOE_WSCALE, 0u, false); o.y = __builtin_amdgcn_cvt_pk_fp8_f32(v[6][j] * MOE_WSCALE, v[7][j] * MOE_WSCALE, w, true);
            w = __builtin_amdgcn_cvt_pk_fp8_f32(v[8][j] * MOE_WSCALE, v[9][j] * MOE_WSCALE, 0u, false); o.z = __builtin_amdgcn_cvt_pk_fp8_f32(v[10][j] * MOE_WSCALE, v[11][j] * MOE_WSCALE, w, true);
            w = __builtin_amdgcn_cvt_pk_fp8_f32(v[12][j] * MOE_WSCALE, v[13][j] * MOE_WSCALE, 0u, false); o.w = __builtin_amdgcn_cvt_pk_fp8_f32(v[14][j] * MOE_WSCALE, v[15][j] * MOE_WSCALE, w, true);
            __builtin_nontemporal_store(o, (u32x4*)dst);
        } else { u32x4 o0, o1;
            o0.x = pk2(v[0][j], v[1][j]); o0.y = pk2(v[2][j], v[3][j]); o0.z = pk2(v[4][j], v[5][j]); o0.w = pk2(v[6][j], v[7][j]);
            o1.x = pk2(v[8][j], v[9][j]); o1.y = pk2(v[10][j], v[11][j]); o1.z = pk2(v[12][j], v[13][j]); o1.w = pk2(v[14][j], v[15][j]);
            ((u32x4*)dst)[0] = o0; ((u32x4*)dst)[1] = o1; }
    }
}
__device__ __forceinline__ void moe_convert(const Frame& F, int wk, int nwk, int lane, const int mode = 0, const int lo = 0, const int MOE_HI = MOE_ITEMS) {
    int it = lo + wk; if (it >= MOE_HI) return;
    f32x4 va[16], vb[16], vc[16];
    if (mode == 2) { _Pragma("unroll") for (int q = 0; q < 16; ++q) { va[q] = (f32x4){1.f, 2.f, 3.f, 4.f}; vb[q] = va[q]; vc[q] = va[q]; } }
    MoeItem ma = moe_item(F, it, mode == 3), mb = ma, mc = ma;
    if (mode != 2) moe_load(ma, lane, va, mode == 3);
    if (it + nwk < MOE_HI) { mb = moe_item(F, it + nwk, mode == 3); if (mode != 2) moe_load(mb, lane, vb, mode == 3); }
#define MOE_STEP(MS, VS, ML, VL) { const bool more2 = it + 2 * nwk < MOE_HI; if (more2) { ML = moe_item(F, it + 2 * nwk, mode == 3); if (mode != 2) moe_load(ML, lane, VL, mode == 3); } \
        if (mode == 1 || mode == 3) { _Pragma("unroll") for (int q = 0; q < 16; ++q) asm volatile("" :: "v"(VS[q])); } \
        else { if (mode == 2) MS.WT = (unsigned char*)F.act + (MS.WT - (unsigned char*)F.WupT); moe_store(MS, lane, VS); } \
        it += nwk; if (it >= MOE_HI) break; }
    for (;;) {
        MOE_STEP(ma, va, mc, vc)
        MOE_STEP(mb, vb, ma, va)
        MOE_STEP(mc, vc, mb, vb)
    }
#undef MOE_STEP
}
__device__ __forceinline__ void p0_fold_item(const Frame& F, LAS float* scr, int item, int lane) {
    const int kb = item >> 6, nb = item & 63, k0 = 16 * kb, g = k0 >> 7, c0 = k0 & 127, n0 = 32 * nb, nn = lane & 31, kh = lane >> 5;
    float acc[8];
#pragma unroll
    for (int i = 0; i < 8; ++i) acc[i] = 0.f;
    const float* wg = F.w_pg + (size_t)(g * 128 + c0 + kh) * 128;
#pragma unroll 4
    for (int d = 0; d < 128; ++d) {
        const float wp = F.w_pp[(size_t)(g * 128 + d) * D + n0 + nn] * F.pool_scale[g * 128 + d];
#pragma unroll
        for (int i = 0; i < 8; ++i) acc[i] += wg[(size_t)(2 * i) * 128 + d] * wp;
    }
#pragma unroll
    for (int i = 0; i < 8; ++i) scr[(2 * i + kh) * 33 + nn] = acc[i];
    LDS_WAIT();
    { const int n = lane >> 1, hf = lane & 1; const LAS float* s = scr + (8 * hf) * 33 + n;
      u32x4 o; o.x = pk2(s[0 * 33], s[1 * 33]); o.y = pk2(s[2 * 33], s[3 * 33]); o.z = pk2(s[4 * 33], s[5 * 33]); o.w = pk2(s[6 * 33], s[7 * 33]);
      *(u32x4*)(F.WcatT + (size_t)(n0 + n) * D + k0 + 8 * hf) = o; }
    LDS_WAIT();
}
__device__ __forceinline__ void rms_row_to_bf16(const float* xrow, const float* gain, bf16_t* orow, int lane, unsigned char* orow8 = nullptr) {
    const f32x4* xr = (const f32x4*)xrow + lane; const f32x4* gr = (const f32x4*)gain + lane;
    f32x4 v[8]; float s = 0.f;
#pragma unroll
    for (int j = 0; j < 8; ++j) { v[j] = xr[64 * j]; s += (v[j].x * v[j].x + v[j].y * v[j].y) + (v[j].z * v[j].z + v[j].w * v[j].w); }
    const float r = __builtin_amdgcn_rsqf(wave_sum(s) * (1.f / D) + NORM_EPS);
    u32x2* o8 = (u32x2*)orow + lane;
#pragma unroll
    for (int j = 0; j < 8; ++j) { const f32x4 g = gr[64 * j]; const f32x4 y = {v[j].x * r * g.x, v[j].y * r * g.y, v[j].z * r * g.z, v[j].w * r * g.w};
        u32x2 o; o.x = pk2(y.x, y.y); o.y = pk2(y.z, y.w); o8[64 * j] = o;
        if (orow8) { const unsigned t = __builtin_amdgcn_cvt_pk_fp8_f32(y.x, y.y, 0u, false); ((unsigned*)orow8)[lane + 64 * j] = __builtin_amdgcn_cvt_pk_fp8_f32(y.z, y.w, t, true); } }
}
__device__ __forceinline__ void p0_prep(const Frame& F) {
    LAS float* scr = (LAS float*)(F.lds + F.wave * 16384);
    const int gw = F.bid * 8 + F.wave, NGW = F.G * 8, lane = F.lane;
    constexpr int I_FOLD = 2048, I_IN = 32 * (P1_NBF * 4), I_IN8 = 32 * (P1_NF8 * 4), I_MKV = 32 * 16, I_AP = 16 * 32, I_MP = 8 * 32, I_OUT = 32 * 32;
    constexpr int I_XN = NTOK, I_MN = NMEMROW, I_WRF = 32;
    constexpr int NITEMS = I_FOLD + I_IN + I_IN8 + I_MKV + I_AP + I_MP + I_OUT + I_XN + I_MN + I_WRF;
    const int nmine = (NITEMS - gw + NGW - 1) / NGW;
    for (int it = gw, jj = 0; it < NITEMS; it += NGW, ++jj) {
        int r = (F.bid & 1) ? gw + (nmine - 1 - jj) * NGW : it;
        if (r < I_FOLD) { p0_fold_item(F, scr, r, lane); continue; } r -= I_FOLD;
        if (r < I_XN) { rms_row_to_bf16(F.x + (size_t)r * D, F.g1, F.xn + (size_t)r * D, lane, P1_FP8_TILES ? F.xn8 + (size_t)r * D : nullptr); continue; } r -= I_XN;
        if (r < I_MN) { rms_row_to_bf16(F.mem + (size_t)r * D, F.gmem, F.mn + (size_t)r * D, lane); continue; } r -= I_MN;
        if (r < I_IN) { const int kb = r & 31, q = r >> 5, nb = p1_tile_bf(q >> 2) * 4 + (q & 3); f32x4 v[16];
            tr_load(F.w_in, IN_W, kb, nb, lane, v); tr_store<false>(v, (unsigned char*)F.WinT, (size_t)D * 2, 0, kb, nb, 1.0f, lane); continue; } r -= I_IN;
        if (r < I_IN8) { const int kb = r & 31, q = r >> 5, nbs = p1_tile_f8(q >> 2) * 4 + (q & 3); f32x4 v[16];
            tr_load(F.w_in, IN_W, kb, nbs, lane, v); tr_store<true>(v, F.Win8, (size_t)D, 0, kb, q, 64.0f, lane); continue; } r -= I_IN8;
        if (r < I_MKV) { p0_transpose_item(F.w_mkv, 1024, D, F.WmkvT, D, 0, r, lane); continue; } r -= I_MKV;
        if (r < I_AP) { if (P4_FP8) { const int kb = r & 15, nb = r >> 4; f32x4 v[16]; tr_load(F.w_ap, D, kb, nb, lane, v); tr_store<true>(v, F.Wcat8, (size_t)1536, 0, kb, nb, 64.0f, lane); }
                        else p0_transpose_item(F.w_ap, D, 1024, F.WcatT, D, 512, r, lane); continue; } r -= I_AP;
        if (r < I_MP) { if (P4_FP8) { const int kb = r & 7, nb = r >> 3; f32x4 v[16]; tr_load(F.w_mp, D, kb, nb, lane, v); tr_store<true>(v, F.Wcat8, (size_t)1536, 1024, kb, nb, 64.0f, lane); }
                        else p0_transpose_item(F.w_mp, D, 512, F.WcatT, D, 1536, r, lane); continue; } r -= I_MP;
        if (r < I_OUT) { p0_transpose_item(F.w_out, D, D, F.WoutT, D, 0, r, lane); continue; } r -= I_OUT;
        { for (int i = r * 2048 + lane; i < (r + 1) * 2048; i += 64) { const float v = F.w_r[i] * F.g2[i >> 5]; const bf16_t hi = f2bf(v); F.wrf[i] = v; F.wrh[(size_t)(i & 31) * D + (i >> 5)] = hi; F.wrl[(size_t)(i & 31) * D + (i >> 5)] = f2bf(v - bf2f(hi)); } }
    }
#if !MOE_CONV_IN_P1 || MOE_PROBE
    moe_convert(F, gw, NGW, lane);
#endif
}

constexpr int MOE_EXTRA = 10;
#ifndef MOE_SIDE_A_FIRST
#define MOE_SIDE_A_FIRST 1
#endif
#ifndef MOE_SIDE_B_AFTER
#define MOE_SIDE_B_AFTER 99
#endif
__device__ __forceinline__ void moe_side(const Frame& F, int G, int c) {
    const int wave = (int)__builtin_amdgcn_readfirstlane(threadIdx.x >> 6), lane = threadIdx.x & 63;
    const int rem = (64 * P1_NBF + 16) % G, nlight = rem ? G - rem : 0, m1 = MOE_ITEMS - nlight * 8 * MOE_EXTRA;
    moe_convert(F, c * 8 + wave, G * 8, lane, MOE_PROBE, 0, m1);
    if (rem && c >= rem) moe_convert(F, (c - rem) * 8 + wave, nlight * 8, lane, MOE_PROBE, m1, MOE_ITEMS);
    asm volatile("s_waitcnt vmcnt(0)" ::: "memory");
}

struct SchedP1 {
    static constexpr bool SIDE_FIRST = MOE_SIDE_A_FIRST != 0;
    __device__ __forceinline__ size_t kstep_a() const { return 128; }
    __device__ __forceinline__ size_t kstep_b() const { return 128; }
    const Frame* F;
#if MOE_CONV_IN_P1
    __device__ __forceinline__ bool side_due(int ui) const { return c * 2 < G; }
    __device__ __forceinline__ void side() const { if (c * 2 < G) moe_side(*F, G, c); }
#else
    __device__ __forceinline__ bool side_due(int) const { return false; } __device__ __forceinline__ void side() const {}
#endif
    static constexpr bool GATHER = false, FP8 = false; static constexpr int SCALE_B = 0x7f7f7f7f;
    int lda, ldb, G, c; const char *xn, *mn, *WinT, *WmkvT;
    __device__ __forceinline__ bool next(int i, Unit& u) const {
        const int L = i * G + c; constexpr int NT = P1_NBF, N1 = 64 * NT;
        if (L < N1) { int b; pg8::tile_of(L, 64, NT, u.pm, b); u.pn = p1_tile_bf(b); u.aux = 0; return true; }
        if (L < N1 + 16) { const int j = L - N1; u.pm = j >> 2; u.pn = j & 3; u.aux = 1; return true; }
        return false;
    }
    __device__ __forceinline__ const char* a_base(const Unit& u) const { return (u.aux ? mn : xn) + (size_t)u.pm * 256 * D * 2; }
    __device__ __forceinline__ const char* b_base(const Unit& u) const { return (u.aux ? WmkvT : WinT) + (size_t)u.pn * 256 * D * 2; }
    __device__ __forceinline__ int nt(const Unit&) const { return D / 64; }
    __device__ __forceinline__ unsigned gather(const Unit&, int, int) const { return 0u; }
};
struct SchedP1b {
    static constexpr bool SIDE_FIRST = false;
    __device__ __forceinline__ size_t kstep_a() const { return 128; }
    __device__ __forceinline__ size_t kstep_b() const { return 128; }
    const Frame* F;
#if MOE_CONV_IN_P1
    __device__ __forceinline__ bool side_due(int ui) const { return c * 2 >= G && ui >= MOE_SIDE_B_AFTER; }
    __device__ __forceinline__ void side() const { if (c * 2 >= G) moe_side(*F, G, c); }
#else
    __device__ __forceinline__ bool side_due(int) const { return false; } __device__ __forceinline__ void side() const {}
#endif
    static constexpr bool GATHER = false, FP8 = true; static constexpr int SCALE_B = 0x79797979;
    int lda, ldb, G, c; const char *xn8, *Win8;
    __device__ __forceinline__ bool next(int i, Unit& u) const {
        const int L = i * G + c; if (L >= 64 * P1_NF8) return false;
        int f; pg8::tile_of(L, 64, P1_NF8 ? P1_NF8 : 1, u.pm, f); u.pn = p1_tile_f8(f); u.aux = 0; return true;
    }
    __device__ __forceinline__ const char* a_base(const Unit& u) const { return xn8 + (size_t)u.pm * 256 * D; }
    __device__ __forceinline__ const char* b_base(const Unit& u) const { return Win8 + (size_t)p1_f8_index(u.pn) * 256 * D; }
    __device__ __forceinline__ int nt(const Unit&) const { return D / 128; }
    __device__ __forceinline__ unsigned gather(const Unit&, int, int) const { return 0u; }
};
struct EpiP1 {
    static constexpr bool PROBE_TWICE = (MK_EPI_TWICE == 1);
    static constexpr int MODE = 1;
    bf16_t* proj; bf16_t* kvraw; const float* b_gate; unsigned char* gate8;
    struct Pre { f32x4 bv[2][2]; };
    __device__ __forceinline__ Pre prefetch(const Unit& u, int wc, int fq) const { Pre p; const int cw = u.pn * 256 + wc * 64 + fq * 16; const bool gate = (u.aux == 0) && (u.pn >= OFF_GATE / 256);
#pragma unroll
        for (int bj = 0; bj < 2; ++bj)
#pragma unroll
            for (int n = 0; n < 2; ++n) p.bv[bj][n] = gate ? *(const f32x4*)(b_gate + (cw - OFF_GATE) + bj * 8 + n * 4) : (f32x4){0.f, 0.f, 0.f, 0.f};
        return p; }
    __device__ __forceinline__ void operator()(const f32x4 (&acc)[2][2][4][2], const Unit& u, int wr, int wc, int fr, int fq, const Pre& pre) const {
        const int row0 = u.pm * 256 + wr * 64 + fr, cw = u.pn * 256 + wc * 64 + fq * 16;
        bf16_t* base; int ldc; const bool gate = (u.aux == 0) && (u.pn >= OFF_GATE / 256), g8 = GATE_BC_FP8 && (u.aux == 0) && (u.pn >= 18);
        if (u.aux == 0) { base = proj + cw; ldc = IN_W; } else { base = kvraw + cw; ldc = 1024; }
        const f32x4 (&bv)[2][2] = pre.bv;
#pragma unroll
        for (int ai = 0; ai < 2; ++ai)
#pragma unroll
            for (int m = 0; m < 4; ++m) { bf16_t* rowp = base + (size_t)(row0 + ai * 128 + m * 16) * ldc; u32x4 w8;
#pragma unroll
                for (int bj = 0; bj < 2; ++bj) { f32x4 v0 = acc[ai][bj][m][0] + bv[bj][0], v1 = acc[ai][bj][m][1] + bv[bj][1];
                    if (gate) {
                        f32x4 d0 = v0 * (f32x4){-LOG2E, -LOG2E, -LOG2E, -LOG2E}, d1 = v1 * (f32x4){-LOG2E, -LOG2E, -LOG2E, -LOG2E};
#pragma unroll
                        for (int j = 0; j < 4; ++j) { d0[j] = __builtin_amdgcn_exp2f(d0[j]); d1[j] = __builtin_amdgcn_exp2f(d1[j]); }
                        d0 += (f32x4){1.0f, 1.0f, 1.0f, 1.0f}; d1 += (f32x4){1.0f, 1.0f, 1.0f, 1.0f};
#pragma unroll
                        for (int j = 0; j < 4; ++j) { v0[j] = __builtin_amdgcn_rcpf(d0[j]); v1[j] = __builtin_amdgcn_rcpf(d1[j]); } }
                    if (g8) { unsigned t = __builtin_amdgcn_cvt_pk_fp8_f32(v0[0], v0[1], 0u, false); const unsigned a = __builtin_amdgcn_cvt_pk_fp8_f32(v0[2], v0[3], t, true);
                        t = __builtin_amdgcn_cvt_pk_fp8_f32(v1[0], v1[1], 0u, false); const unsigned b = __builtin_amdgcn_cvt_pk_fp8_f32(v1[2], v1[3], t, true);
                        if (bj == 0) { w8.x = a; w8.y = b; } else { w8.z = a; w8.w = b; } }
                    else { u32x4 w; w.x = pk2(v0[0], v0[1]); w.y = pk2(v0[2], v0[3]); w.z = pk2(v1[0], v1[1]); w.w = pk2(v1[2], v1[3]);
                        *(u32x4*)(rowp + bj * 8) = w; } }
                if (g8) *(u32x4*)(gate8 + (size_t)(row0 + ai * 128 + m * 16) * (2 * D) + (cw - 18 * 256)) = w8; }
    }
};

__device__ __forceinline__ float row16_sum(float v) {
    v += __builtin_bit_cast(float, __builtin_amdgcn_update_dpp(0, __builtin_bit_cast(int, v), 0xB1, 0xf, 0xf, true));
    v += __builtin_bit_cast(float, __builtin_amdgcn_update_dpp(0, __builtin_bit_cast(int, v), 0x4E, 0xf, 0xf, true));
    v += __builtin_bit_cast(float, __builtin_amdgcn_update_dpp(0, __builtin_bit_cast(int, v), 0x141, 0xf, 0xf, true));
    v += __builtin_bit_cast(float, __builtin_amdgcn_update_dpp(0, __builtin_bit_cast(int, v), 0x140, 0xf, 0xf, true));
    return v;
}
__device__ __forceinline__ float row_ror8(float v) { return __builtin_bit_cast(float, __builtin_amdgcn_update_dpp(0, __builtin_bit_cast(int, v), 0x128, 0xf, 0xf, true)); }
__device__ __forceinline__ void p2_token(const Frame& F, int t, int lane) {
    const int s = t % SEQ; const int b = t / SEQ;
    const bf16_t* prow = F.proj + (size_t)t * IN_W;
    const int row = lane >> 4, j = lane & 15, jf = j & 7;
    const float posf = (float)F.pos[t];
    float cs[8], sn[8];
#pragma unroll
    for (int e = 0; e < 8; ++e) {
        const float inv_freq = __builtin_amdgcn_exp2f(-(float)(8 * jf + e) * (13.287712379549449f / 64.0f)), ang = posf * inv_freq, kq = __builtin_rintf(ang * 0.15915494309189535f);
        float rr = __builtin_fmaf(-kq, 6.2831854820251465f, ang); rr = __builtin_fmaf(-kq, -1.7484556000744883e-07f, rr);
        cs[e] = __cosf(rr); sn[e] = j < 8 ? -__sinf(rr) : __sinf(rr); }
#pragma unroll
    for (int pass = 0; pass < 4; ++pass) {
        const int hidx = 4 * pass + row; const bool active = hidx < 14, isq = hidx < 8, isk = hidx >= 8 && hidx < 10;
        const int hh = isq ? hidx : (isk ? hidx - 8 : (active ? hidx - 10 : 0));
        const bf16_t* src = prow + (isq ? OFF_Q : (isk ? OFF_K : OFF_MQ)) + hh * 128 + 8 * j;
        const float* gp = (isq ? F.gq : (isk ? F.gk : F.gmq)) + 8 * j;
        bf16_t* dst = (isq ? F.qn + (size_t)t * 1024 : (isk ? F.kn + (size_t)t * 256 : F.mqn + (size_t)t * 512)) + hh * 128 + 8 * j;
        const u32x4 raw = *(const u32x4*)src; const f32x4 g0 = *(const f32x4*)gp, g1 = *(const f32x4*)(gp + 4);
        float v[8] = {bflo(raw.x), bfhi(raw.x), bflo(raw.y), bfhi(raw.y), bflo(raw.z), bfhi(raw.z), bflo(raw.w), bfhi(raw.w)};
        float ss = 0.f;
#pragma unroll
        for (int e = 0; e < 8; ++e) ss += v[e] * v[e];
        const float r = __builtin_amdgcn_rsqf(row16_sum(ss) * (1.f / 128.f) + NORM_EPS), sc = isk ? 1.0f : QSCALE; const bool rot = isq || isk;
        const float g[8] = {g0.x, g0.y, g0.z, g0.w, g1.x, g1.y, g1.z, g1.w}; float y[8];
#pragma unroll
        for (int e = 0; e < 8; ++e) { const float a = v[e] * r * g[e], pr = row_ror8(a); y[e] = (rot ? a * cs[e] + pr * sn[e] : a) * sc; }
        u32x4 o; o.x = pk2(y[0], y[1]); o.y = pk2(y[2], y[3]); o.z = pk2(y[4], y[5]); o.w = pk2(y[6], y[7]);
        if (active) *(u32x4*)dst = o;
    }
    {
        const int g = lane >> 4, w = 2 << g; int lo = s - (w >> 1), hi = lo + w; lo = lo < 0 ? 0 : lo; hi = hi > SEQ ? SEQ : hi;
        float a[8];
#pragma unroll
        for (int j = 0; j < 8; ++j) a[j] = 0.f;
        const bf16_t* up = F.proj + (size_t)(b * SEQ) * IN_W + OFF_POOL + lane * 8;
        u32x4 wv[16];
#pragma unroll
        for (int jj = 0; jj < 16; ++jj) { const int rj = s - 8 + jj; wv[jj] = (rj >= lo && rj < hi) ? *(const u32x4*)(up + (size_t)rj * IN_W) : (u32x4){0u, 0u, 0u, 0u}; }
#pragma unroll
        for (int jj = 0; jj < 16; ++jj) { const u32x4 v = wv[jj];
            a[0] += bflo(v.x); a[1] += bfhi(v.x); a[2] += bflo(v.y); a[3] += bfhi(v.y); a[4] += bflo(v.z); a[5] += bfhi(v.z); a[6] += bflo(v.w); a[7] += bfhi(v.w); }
        const u32x4 me = *(const u32x4*)(up + (size_t)s * IN_W); const float ic = 1.0f / (float)(hi - lo);
        u32x4 o; o.x = pk2(a[0] * ic - bflo(me.x), a[1] * ic - bfhi(me.x)); o.y = pk2(a[2] * ic - bflo(me.y), a[3] * ic - bfhi(me.y));
        o.z = pk2(a[4] * ic - bflo(me.z), a[5] * ic - bfhi(me.z)); o.w = pk2(a[6] * ic - bflo(me.w), a[7] * ic - bfhi(me.w));
        *(u32x4*)(F.acat + (size_t)t * D + lane * 8) = o;
    }
}
__device__ __forceinline__ void p2_transpose64(const bf16_t* src, int src_ld, bf16_t* dst, int dst_ld, LAS bf16_t* scr, int lane) {
    const bf16_t* sp = src + (size_t)lane * src_ld;
#pragma unroll
    for (int i = 0; i < 8; ++i) { const u32x4 v = *(const u32x4*)(sp + 8 * i);
        scr[(8 * i + 0) * 66 + lane] = (bf16_t)(v.x & 0xffff); scr[(8 * i + 1) * 66 + lane] = (bf16_t)(v.x >> 16); scr[(8 * i + 2) * 66 + lane] = (bf16_t)(v.y & 0xffff); scr[(8 * i + 3) * 66 + lane] = (bf16_t)(v.y >> 16);
        scr[(8 * i + 4) * 66 + lane] = (bf16_t)(v.z & 0xffff); scr[(8 * i + 5) * 66 + lane] = (bf16_t)(v.z >> 16); scr[(8 * i + 6) * 66 + lane] = (bf16_t)(v.w & 0xffff); scr[(8 * i + 7) * 66 + lane] = (bf16_t)(v.w >> 16); }
    LDS_WAIT();
    const LAS unsigned* rp = (const LAS unsigned*)(scr + lane * 66);
    bf16_t* dp = dst + (size_t)lane * dst_ld;
#pragma unroll
    for (int i = 0; i < 8; ++i) { u32x4 o; o.x = rp[4 * i]; o.y = rp[4 * i + 1]; o.z = rp[4 * i + 2]; o.w = rp[4 * i + 3]; *(u32x4*)(dp + 8 * i) = o; }
    LDS_WAIT();
}
__device__ __forceinline__ void p2_prepass(const Frame& F) {
    LAS bf16_t* scr = (LAS bf16_t*)(F.lds + F.wave * 16384);
    const int gw = F.bid * 8 + F.wave, NGW = F.G * 8, lane = F.lane;
    constexpr int J_VT = NBATCH * 2 * 64 * 2, J_MVT = NBATCH * 4 * 4 * 2, J_MK = NMEMROW, J_TOK = NTOK;
    for (int it = gw; it < J_VT + J_MVT + J_MK + J_TOK; it += NGW) {
        int r = it;
        if (r < J_VT) { const int dc = r & 1, tj = (r >> 1) & 63, kvh = (r >> 7) & 1, b = r >> 8;
            p2_transpose64(F.proj + (size_t)(b * SEQ + 64 * tj) * IN_W + OFF_V + kvh * 128 + 64 * dc, IN_W, F.vT + ((size_t)((b * 2 + kvh) * 128 + 64 * dc)) * SEQ + 64 * tj, SEQ, scr, lane); continue; } r -= J_VT;
        if (r < J_MVT) { const int dc = r & 1, tj = (r >> 1) & 3, h = (r >> 3) & 3, b = r >> 5;
            p2_transpose64(F.kvraw + (size_t)(b * MEMLEN + 64 * tj) * 1024 + 512 + h * 128 + 64 * dc, 1024, F.mvT + ((size_t)((b * 4 + h) * 128 + 64 * dc)) * MEMLEN + 64 * tj, MEMLEN, scr, lane); continue; } r -= J_MVT;
        if (r < J_MK) { const float g1 = F.gmk[lane], g2 = F.gmk[64 + lane];
#pragma unroll
            for (int hd = 0; hd < 4; ++hd) { const float x1 = bf2f(F.kvraw[(size_t)r * 1024 + hd * 128 + lane]), x2 = bf2f(F.kvraw[(size_t)r * 1024 + hd * 128 + 64 + lane]);
                const float q = __builtin_amdgcn_rsqf(wave_sum(x1 * x1 + x2 * x2) * (1.f / 128.f) + NORM_EPS);
                F.mk[(size_t)r * 512 + hd * 128 + lane] = f2bf(x1 * q * g1); F.mk[(size_t)r * 512 + hd * 128 + 64 + lane] = f2bf(x2 * q * g2); }
            continue; } r -= J_MK;
        p2_token(F, r, lane);
    }
}

constexpr int AT_KROW = 272, AT_VROW = 144, AT_KBYTES = 64 * AT_KROW, AT_VBYTES = 128 * AT_VROW, AT_BUF = AT_KBYTES + AT_VBYTES;
template <bool LOCAL>
__device__ __forceinline__ void attn_unit(const Frame& F, const bf16_t* qrow, const bf16_t* kbase, int k_ld, const bf16_t* vtbase, int vt_ld,
                                          int kt_lo, int ntile, int qi, float m0, float l0, bf16_t* orow, unsigned char* orow8) {
    LAS unsigned char* lds = F.lds; const int tid = F.tid, lane = F.lane, r = lane & 31, h = lane >> 5;
    const int kr = (r & 0x13) | ((r & 4) << 1) | ((r & 8) >> 1);
    bf16x8 qf[8];
#pragma unroll
    for (int st = 0; st < 8; ++st) qf[st] = *(const bf16x8*)(qrow + 16 * st + 8 * h);
    f32x16 oacc[4];
#pragma unroll
    for (int md = 0; md < 4; ++md)
#pragma unroll
        for (int i = 0; i < 16; ++i) oacc[md][i] = 0.f;
    float mrun = m0, lrun = l0;
    const int kp_row0 = tid >> 4, kp_c = tid & 15, vp_row0 = tid >> 3, vp_c = tid & 7;
    u32x4 kreg[2], vreg[2];
#define AT_LOAD(ks) do { _Pragma("unroll") for (int i = 0; i < 2; ++i) { \
        kreg[i] = *(const u32x4*)(kbase + (size_t)((ks) + kp_row0 + 32 * i) * k_ld + kp_c * 8); \
        vreg[i] = *(const u32x4*)(vtbase + (size_t)(vp_row0 + 64 * i) * vt_ld + (ks) + vp_c * 8); } } while (0)
#define AT_WRITE(buf) do { _Pragma("unroll") for (int i = 0; i < 2; ++i) { \
        *(LAS u32x4*)(lds + (buf) * AT_BUF + (kp_row0 + 32 * i) * AT_KROW + kp_c * 16) = kreg[i]; \
        *(LAS u32x4*)(lds + (buf) * AT_BUF + AT_KBYTES + (vp_row0 + 64 * i) * AT_VROW + vp_c * 16) = vreg[i]; } } while (0)
    AT_LOAD(kt_lo); AT_WRITE(0);
    __syncthreads();
#pragma unroll 1
    for (int j = 0; j < ntile; ++j) {
        const int ks = kt_lo + 64 * j; const bool more = (j + 1 < ntile);
        if (more) AT_LOAD(ks + 64);
        LAS unsigned char* kb = lds + (j & 1) * AT_BUF; LAS unsigned char* vb = kb + AT_KBYTES;
        f32x16 sacc[2];
#pragma unroll
        for (int mt = 0; mt < 2; ++mt)
#pragma unroll
            for (int i = 0; i < 16; ++i) sacc[mt][i] = 0.f;
#pragma unroll
        for (int st = 0; st < 8; ++st) {
#pragma unroll
            for (int mt = 0; mt < 2; ++mt) { const bf16x8 kf = *(const LAS bf16x8*)(kb + (32 * mt + kr) * AT_KROW + (16 * st + 8 * h) * 2);
                sacc[mt] = __builtin_amdgcn_mfma_f32_32x32x16_bf16(kf, qf[st], sacc[mt], 0, 0, 0); }
            if (st == 3) __builtin_amdgcn_sched_barrier(0);
        }
        __builtin_amdgcn_sched_barrier(0);
        float mx = -1e30f;
        const int q0w = __builtin_amdgcn_readfirstlane(qi - r);
        if (LOCAL && (ks - (q0w + 31) < -128 || ks + 63 - q0w > 128)) { const int dk = ks + 8 * h - qi;
#pragma unroll
            for (int mt = 0; mt < 2; ++mt)
#pragma unroll
                for (int i = 0; i < 16; ++i) { const int d = dk + 32 * mt + (i & 3) + 4 * ((i >> 2) & 1) + 16 * (i >> 3);
                    const float v = (d >= -128 && d <= 128) ? sacc[mt][i] : -1e30f; sacc[mt][i] = v; mx = fmaxf(mx, v); }
        } else {
#pragma unroll
            for (int mt = 0; mt < 2; ++mt)
#pragma unroll
                for (int i = 0; i < 16; ++i) mx = fmaxf(mx, sacc[mt][i]);
        }
        mx = fmaxf(mx, __shfl_xor(mx, 32));
        const float mnew = fmaxf(mrun, mx), alpha = __builtin_amdgcn_exp2f(mrun - mnew);
        mrun = mnew;
        float ls = 0.f;
#pragma unroll
        for (int mt = 0; mt < 2; ++mt)
#pragma unroll
            for (int i = 0; i < 16; ++i) { const float p = __builtin_amdgcn_exp2f(sacc[mt][i] - mnew); sacc[mt][i] = p; ls += p; }
        lrun = lrun * alpha + ls;
#pragma unroll
        for (int md = 0; md < 4; ++md)
#pragma unroll
            for (int i = 0; i < 16; ++i) oacc[md][i] *= alpha;
        bf16x8 pf[2][2];
#pragma unroll
        for (int mt = 0; mt < 2; ++mt)
#pragma unroll
            for (int s2 = 0; s2 < 2; ++s2) { u32x4 p; p.x = pk2(sacc[mt][8 * s2 + 0], sacc[mt][8 * s2 + 1]); p.y = pk2(sacc[mt][8 * s2 + 2], sacc[mt][8 * s2 + 3]);
                p.z = pk2(sacc[mt][8 * s2 + 4], sacc[mt][8 * s2 + 5]); p.w = pk2(sacc[mt][8 * s2 + 6], sacc[mt][8 * s2 + 7]); pf[mt][s2] = __builtin_bit_cast(bf16x8, p); }
#pragma unroll
        for (int mt = 0; mt < 2; ++mt)
#pragma unroll
            for (int s2 = 0; s2 < 2; ++s2) {
#pragma unroll
                for (int md = 0; md < 4; ++md) { const bf16x8 vf = *(const LAS bf16x8*)(vb + (32 * md + r) * AT_VROW + (32 * mt + 16 * s2 + 8 * h) * 2);
                    oacc[md] = __builtin_amdgcn_mfma_f32_32x32x16_bf16(vf, pf[mt][s2], oacc[md], 0, 0, 0); }
                __builtin_amdgcn_sched_barrier(0); }
        if (more) AT_WRITE((j + 1) & 1);
        __syncthreads();
    }
#undef AT_LOAD
#undef AT_WRITE
    const float ltot = lrun + __shfl_xor(lrun, 32), inv = 1.0f / ltot;
#pragma unroll
    for (int md = 0; md < 4; ++md)
#pragma unroll
        for (int g4 = 0; g4 < 4; ++g4) { u32x2 o; o.x = pk2(oacc[md][4 * g4] * inv, oacc[md][4 * g4 + 1] * inv); o.y = pk2(oacc[md][4 * g4 + 2] * inv, oacc[md][4 * g4 + 3] * inv);
            if (P4_FP8) { const unsigned t = __builtin_amdgcn_cvt_pk_fp8_f32(oacc[md][4 * g4] * inv, oacc[md][4 * g4 + 1] * inv, 0u, false);
                *(unsigned*)(orow8 + 32 * md + 8 * g4 + 4 * h) = __builtin_amdgcn_cvt_pk_fp8_f32(oacc[md][4 * g4 + 2] * inv, oacc[md][4 * g4 + 3] * inv, t, true); }
            else *(u32x2*)(orow + 32 * md + 8 * g4 + 4 * h) = o; }
}
__device__ __forceinline__ void p3_attention(const Frame& F) {
    const int w = F.wave, r = F.lane & 31, h = F.lane >> 5;
    const bool xmap = (F.G == 256);
    for (int uu = F.bid, jr = 0; uu < 512 + 256; uu += F.G, ++jr) {
        const int u = !xmap ? uu : (jr < 2 ? 64 * (F.bid & 7) + 32 * jr + (F.bid >> 3) : 512 + 32 * (F.bid & 7) + (F.bid >> 3));
        if (u < 512) {
            const int b = u >> 7, kvh = (u >> 6) & 1, qt = u & 63, g = w >> 1, sub = w & 1, head = kvh * 4 + g;
            const int Q0 = qt * 64, qi = Q0 + sub * 32 + r, t = b * SEQ + qi;
            int lo = Q0 - 128; lo = lo < 0 ? 0 : lo; int hi = Q0 + 192; hi = hi > SEQ ? SEQ : hi;
            attn_unit<true>(F, F.qn + (size_t)t * 1024 + head * 128, F.kn + (size_t)(b * SEQ) * 256 + kvh * 128, 256, F.vT + (size_t)((b * 2 + kvh) * 128) * SEQ, SEQ,
                            lo, (hi - lo) >> 6, qi, F.sink[head] * LOG2E, h == 0 ? 1.0f : 0.0f, F.acat + (size_t)t * D + 512 + head * 128, F.acat8 + (size_t)t * 1536 + head * 128);
        } else {
            const int v = u - 512, b = v >> 6, hm = (v >> 4) & 3, qb = v & 15, qi = qb * 256 + w * 32 + r, t = b * SEQ + qi;
            attn_unit<false>(F, F.mqn + (size_t)t * 512 + hm * 128, F.mk + (size_t)(b * MEMLEN) * 512 + hm * 128, 512, F.mvT + (size_t)((b * 4 + hm) * 128) * MEMLEN, MEMLEN,
                             0, 4, qi, -1e30f, 0.0f, F.acat + (size_t)t * D + 1536 + hm * 128, F.acat8 + (size_t)t * 1536 + 1024 + hm * 128);
        }
    }
}

struct SchedP4 {
    static constexpr bool SIDE_FIRST = false;
    __device__ __forceinline__ size_t kstep_a() const { return 128; }
    __device__ __forceinline__ size_t kstep_b() const { return 128; }
    __device__ __forceinline__ bool side_due(int) const { return false; } __device__ __forceinline__ void side() const {}
    static constexpr bool GATHER = false, FP8 = false; static constexpr int SCALE_B = 0x7f7f7f7f;
    int lda, ldb, G, c; const char *acat, *WcatT;
    __device__ __forceinline__ bool next(int i, Unit& u) const {
        constexpr int NB = P4_FP8 ? 1 : 3; const int i2 = i / NB, br = i - NB * i2, L = i2 * G + c;
        if (L >= 512) return false;
        pg8::tile_of(L, 64, 8, u.pm, u.pn); u.aux = br; return true;
    }
    __device__ __forceinline__ int k0(const Unit& u) const { return u.aux == 0 ? 0 : (u.aux == 1 ? 512 : 1536); }
    __device__ __forceinline__ const char* a_base(const Unit& u) const { return acat + ((size_t)u.pm * 256 * D + k0(u)) * 2; }
    __device__ __forceinline__ const char* b_base(const Unit& u) const { return WcatT + ((size_t)u.pn * 256 * D + k0(u)) * 2; }
    __device__ __forceinline__ int nt(const Unit& u) const { return u.aux == 1 ? 16 : 8; }
    __device__ __forceinline__ unsigned gather(const Unit&, int, int) const { return 0u; }
};
struct SchedP4b {
    static constexpr bool SIDE_FIRST = false;
    __device__ __forceinline__ size_t kstep_a() const { return 128; }
    __device__ __forceinline__ size_t kstep_b() const { return 128; }
    __device__ __forceinline__ bool side_due(int) const { return false; } __device__ __forceinline__ void side() const {}
    static constexpr bool GATHER = false, FP8 = true; static constexpr int SCALE_B = 0x79797979;
    int lda, ldb, G, c; const char *acat8, *Wcat8;
    __device__ __forceinline__ bool next(int i, Unit& u) const {
        const int i2 = i >> 1, L = i2 * G + c;
        if (L >= 512) return false;
        pg8::tile_of(L, 64, 8, u.pm, u.pn); u.aux = 1 + (i & 1); return true;
    }
    __device__ __forceinline__ int k0(const Unit& u) const { return u.aux == 1 ? 0 : 1024; }
    __device__ __forceinline__ const char* a_base(const Unit& u) const { return acat8 + (size_t)u.pm * 256 * 1536 + k0(u); }
    __device__ __forceinline__ const char* b_base(const Unit& u) const { return Wcat8 + (size_t)u.pn * 256 * 1536 + k0(u); }
    __device__ __forceinline__ int nt(const Unit& u) const { return u.aux == 1 ? 8 : 4; }
    __device__ __forceinline__ unsigned gather(const Unit&, int, int) const { return 0u; }
};
#ifndef P4_EPI_BATCH
#define P4_EPI_BATCH 1
#endif
struct EpiP4 {
    static constexpr bool PROBE_TWICE = false;
    static constexpr int MODE = 1;
    const bf16_t* proj; float* scr; bf16_t* merged; const unsigned char* gate8;
#if P4_SMALL_FIRST && GATE_BC_FP8 && P4_EPI_BATCH
    struct Pre { u32x4 g[8]; };
    __device__ __forceinline__ Pre prefetch(const Unit& u, int wc, int fq) const { Pre p;
        const int fr = (int)__builtin_amdgcn_mbcnt_hi(~0u, __builtin_amdgcn_mbcnt_lo(~0u, 0u)) & 15, wr = (int)__builtin_amdgcn_readfirstlane(threadIdx.x >> 8);
        const int row0 = u.pm * 256 + wr * 64 + fr, cw = u.pn * 256 + wc * 64 + fq * 16, br = u.aux;
        if (br > 0) {
#pragma unroll
            for (int j = 0; j < 8; ++j) p.g[j] = *(const u32x4*)(gate8 + (size_t)(row0 + (j >> 2) * 128 + (j & 3) * 16) * (2 * D) + (br - 1) * D + cw);
        } else {
#pragma unroll
            for (int m = 0; m < 4; ++m) { const size_t row = (size_t)(row0 + m * 16); p.g[m] = *(const u32x4*)(proj + row * IN_W + OFF_GATE + cw); p.g[4 + m] = *(const u32x4*)(proj + row * IN_W + OFF_GATE + cw + 8); }
        }
        return p; }
#else
    struct Pre {}; __device__ __forceinline__ Pre prefetch(const Unit&, int, int) const { return Pre{}; }
#endif
#if P4_SMALL_FIRST && GATE_BC_FP8 && P4_EPI_BATCH
    __device__ __forceinline__ void operator()(const f32x4 (&acc)[2][2][4][2], const Unit& u, int wr, int wc, int fr, int fq, const Pre& pre) const {
        const int row0 = u.pm * 256 + wr * 64 + fr, cw = u.pn * 256 + wc * 64 + fq * 16, br = u.aux;
        u32x4* sp = (u32x4*)((f32x4*)scr + (size_t)(u.pm * 8 + u.pn) * 16384 + threadIdx.x);
#pragma unroll
        for (int ai = 0; ai < 2; ++ai) {
            u32x4 ga[4], gb[4], pk[4];
#pragma unroll
            for (int m = 0; m < 4; ++m) { const size_t row = (size_t)(row0 + ai * 128 + m * 16);
                if (br > 0) { ga[m] = pre.g[ai * 4 + m]; gb[m] = ga[m]; }
                else if (ai == 0) { ga[m] = pre.g[m]; gb[m] = pre.g[4 + m]; }
                else { ga[m] = *(const u32x4*)(proj + row * IN_W + OFF_GATE + cw); gb[m] = *(const u32x4*)(proj + row * IN_W + OFF_GATE + cw + 8); }
                if (br != 1) pk[m] = sp[(size_t)((ai * 4 + m) * 4) * 512]; else pk[m] = ga[m]; }
            __builtin_amdgcn_sched_barrier(0);
#pragma unroll
            for (int m = 0; m < 4; ++m) { const size_t row = (size_t)(row0 + ai * 128 + m * 16);
                f32x4 v[2][2];
                if (br > 0) { const u32x4 g = ga[m];
                    const f32x2 a0 = __builtin_amdgcn_cvt_pk_f32_fp8((int)g.x, false), a1 = __builtin_amdgcn_cvt_pk_f32_fp8((int)g.x, true), a2 = __builtin_amdgcn_cvt_pk_f32_fp8((int)g.y, false), a3 = __builtin_amdgcn_cvt_pk_f32_fp8((int)g.y, true);
                    const f32x2 b0 = __builtin_amdgcn_cvt_pk_f32_fp8((int)g.z, false), b1 = __builtin_amdgcn_cvt_pk_f32_fp8((int)g.z, true), b2 = __builtin_amdgcn_cvt_pk_f32_fp8((int)g.w, false), b3 = __builtin_amdgcn_cvt_pk_f32_fp8((int)g.w, true);
                    v[0][0] = acc[ai][0][m][0] * (f32x4){a0.x, a0.y, a1.x, a1.y}; v[0][1] = acc[ai][0][m][1] * (f32x4){a2.x, a2.y, a3.x, a3.y};
                    v[1][0] = acc[ai][1][m][0] * (f32x4){b0.x, b0.y, b1.x, b1.y}; v[1][1] = acc[ai][1][m][1] * (f32x4){b2.x, b2.y, b3.x, b3.y};
                } else { const u32x4 a = ga[m], b = gb[m];
                    v[0][0] = acc[ai][0][m][0] * (f32x4){bflo(a.x), bfhi(a.x), bflo(a.y), bfhi(a.y)}; v[0][1] = acc[ai][0][m][1] * (f32x4){bflo(a.z), bfhi(a.z), bflo(a.w), bfhi(a.w)};
                    v[1][0] = acc[ai][1][m][0] * (f32x4){bflo(b.x), bfhi(b.x), bflo(b.y), bfhi(b.y)}; v[1][1] = acc[ai][1][m][1] * (f32x4){bflo(b.z), bfhi(b.z), bflo(b.w), bfhi(b.w)}; }
                if (br != 1) { const u32x4 g = pk[m];
                    const f32x2 a0 = __builtin_amdgcn_cvt_pk_f32_fp8((int)g.x, false), a1 = __builtin_amdgcn_cvt_pk_f32_fp8((int)g.x, true), a2 = __builtin_amdgcn_cvt_pk_f32_fp8((int)g.y, false), a3 = __builtin_amdgcn_cvt_pk_f32_fp8((int)g.y, true);
                    const f32x2 b0 = __builtin_amdgcn_cvt_pk_f32_fp8((int)g.z, false), b1 = __builtin_amdgcn_cvt_pk_f32_fp8((int)g.z, true), b2 = __builtin_amdgcn_cvt_pk_f32_fp8((int)g.w, false), b3 = __builtin_amdgcn_cvt_pk_f32_fp8((int)g.w, true);
                    v[0][0] += (f32x4){a0.x, a0.y, a1.x, a1.y} * (1.0f / 16.0f); v[0][1] += (f32x4){a2.x, a2.y, a3.x, a3.y} * (1.0f / 16.0f); v[1][0] += (f32x4){b0.x, b0.y, b1.x, b1.y} * (1.0f / 16.0f); v[1][1] += (f32x4){b2.x, b2.y, b3.x, b3.y} * (1.0f / 16.0f); }
                if (br != 0) { u32x4 o; unsigned t;
                    t = __builtin_amdgcn_cvt_pk_fp8_f32(v[0][0][0] * 16.f, v[0][0][1] * 16.f, 0u, false); o.x = __builtin_amdgcn_cvt_pk_fp8_f32(v[0][0][2] * 16.f, v[0][0][3] * 16.f, t, true);
                    t = __builtin_amdgcn_cvt_pk_fp8_f32(v[0][1][0] * 16.f, v[0][1][1] * 16.f, 0u, false); o.y = __builtin_amdgcn_cvt_pk_fp8_f32(v[0][1][2] * 16.f, v[0][1][3] * 16.f, t, true);
                    t = __builtin_amdgcn_cvt_pk_fp8_f32(v[1][0][0] * 16.f, v[1][0][1] * 16.f, 0u, false); o.z = __builtin_amdgcn_cvt_pk_fp8_f32(v[1][0][2] * 16.f, v[1][0][3] * 16.f, t, true);
                    t = __builtin_amdgcn_cvt_pk_fp8_f32(v[1][1][0] * 16.f, v[1][1][1] * 16.f, 0u, false); o.w = __builtin_amdgcn_cvt_pk_fp8_f32(v[1][1][2] * 16.f, v[1][1][3] * 16.f, t, true);
                    sp[(size_t)((ai * 4 + m) * 4) * 512] = o; }
                else { u32x4 w0, w1; w0.x = pk2(v[0][0][0], v[0][0][1]); w0.y = pk2(v[0][0][2], v[0][0][3]); w0.z = pk2(v[0][1][0], v[0][1][1]); w0.w = pk2(v[0][1][2], v[0][1][3]);
                    w1.x = pk2(v[1][0][0], v[1][0][1]); w1.y = pk2(v[1][0][2], v[1][0][3]); w1.z = pk2(v[1][1][0], v[1][1][1]); w1.w = pk2(v[1][1][2], v[1][1][3]);
                    *(u32x4*)(merged + row * D + cw) = w0; *(u32x4*)(merged + row * D + cw + 8) = w1; } }
        }
    }
#else
    __device__ __forceinline__ void operator()(const f32x4 (&acc)[2][2][4][2], const Unit& u, int wr, int wc, int fr, int fq, const Pre&) const {
        const int row0 = u.pm * 256 + wr * 64 + fr, cw = u.pn * 256 + wc * 64 + fq * 16, br = u.aux;
        f32x4* sp = (f32x4*)scr + (size_t)(u.pm * 8 + u.pn) * 16384 + threadIdx.x;
#pragma unroll
        for (int ai = 0; ai < 2; ++ai)
#pragma unroll
            for (int m = 0; m < 4; ++m) { const size_t row = (size_t)(row0 + ai * 128 + m * 16);
                f32x4 v[2][2];
                if (GATE_BC_FP8 && br > 0) { const u32x4 g = *(const u32x4*)(gate8 + row * (2 * D) + (br - 1) * D + cw);
                    const f32x2 a0 = __builtin_amdgcn_cvt_pk_f32_fp8((int)g.x, false), a1 = __builtin_amdgcn_cvt_pk_f32_fp8((int)g.x, true), a2 = __builtin_amdgcn_cvt_pk_f32_fp8((int)g.y, false), a3 = __builtin_amdgcn_cvt_pk_f32_fp8((int)g.y, true);
                    const f32x2 b0 = __builtin_amdgcn_cvt_pk_f32_fp8((int)g.z, false), b1 = __builtin_amdgcn_cvt_pk_f32_fp8((int)g.z, true), b2 = __builtin_amdgcn_cvt_pk_f32_fp8((int)g.w, false), b3 = __builtin_amdgcn_cvt_pk_f32_fp8((int)g.w, true);
                    v[0][0] = acc[ai][0][m][0] * (f32x4){a0.x, a0.y, a1.x, a1.y}; v[0][1] = acc[ai][0][m][1] * (f32x4){a2.x, a2.y, a3.x, a3.y};
                    v[1][0] = acc[ai][1][m][0] * (f32x4){b0.x, b0.y, b1.x, b1.y}; v[1][1] = acc[ai][1][m][1] * (f32x4){b2.x, b2.y, b3.x, b3.y};
                } else {
                const u32x4 ga = *(const u32x4*)(proj + row * IN_W + OFF_GATE + br * D + cw), gb = *(const u32x4*)(proj + row * IN_W + OFF_GATE + br * D + cw + 8);
                v[0][0] = acc[ai][0][m][0] * (f32x4){bflo(ga.x), bfhi(ga.x), bflo(ga.y), bfhi(ga.y)}; v[0][1] = acc[ai][0][m][1] * (f32x4){bflo(ga.z), bfhi(ga.z), bflo(ga.w), bfhi(ga.w)};
                v[1][0] = acc[ai][1][m][0] * (f32x4){bflo(gb.x), bfhi(gb.x), bflo(gb.y), bfhi(gb.y)}; v[1][1] = acc[ai][1][m][1] * (f32x4){bflo(gb.z), bfhi(gb.z), bflo(gb.w), bfhi(gb.w)}; }
                f32x4* s4 = sp + (size_t)((ai * 4 + m) * 4) * 512; u32x4* h4 = (u32x4*)sp + (size_t)((ai * 4 + m) * 4) * 512;
                if (P4_SMALL_FIRST) {
                    if (br != 1) { const u32x4 g = h4[0];
                        const f32x2 a0 = __builtin_amdgcn_cvt_pk_f32_fp8((int)g.x, false), a1 = __builtin_amdgcn_cvt_pk_f32_fp8((int)g.x, true), a2 = __builtin_amdgcn_cvt_pk_f32_fp8((int)g.y, false), a3 = __builtin_amdgcn_cvt_pk_f32_fp8((int)g.y, true);
                        const f32x2 b0 = __builtin_amdgcn_cvt_pk_f32_fp8((int)g.z, false), b1 = __builtin_amdgcn_cvt_pk_f32_fp8((int)g.z, true), b2 = __builtin_amdgcn_cvt_pk_f32_fp8((int)g.w, false), b3 = __builtin_amdgcn_cvt_pk_f32_fp8((int)g.w, true);
                        v[0][0] += (f32x4){a0.x, a0.y, a1.x, a1.y} * (1.0f / 16.0f); v[0][1] += (f32x4){a2.x, a2.y, a3.x, a3.y} * (1.0f / 16.0f); v[1][0] += (f32x4){b0.x, b0.y, b1.x, b1.y} * (1.0f / 16.0f); v[1][1] += (f32x4){b2.x, b2.y, b3.x, b3.y} * (1.0f / 16.0f); }
                    if (br != 0) { u32x4 o; unsigned t;
                        t = __builtin_amdgcn_cvt_pk_fp8_f32(v[0][0][0] * 16.f, v[0][0][1] * 16.f, 0u, false); o.x = __builtin_amdgcn_cvt_pk_fp8_f32(v[0][0][2] * 16.f, v[0][0][3] * 16.f, t, true);
                        t = __builtin_amdgcn_cvt_pk_fp8_f32(v[0][1][0] * 16.f, v[0][1][1] * 16.f, 0u, false); o.y = __builtin_amdgcn_cvt_pk_fp8_f32(v[0][1][2] * 16.f, v[0][1][3] * 16.f, t, true);
                        t = __builtin_amdgcn_cvt_pk_fp8_f32(v[1][0][0] * 16.f, v[1][0][1] * 16.f, 0u, false); o.z = __builtin_amdgcn_cvt_pk_fp8_f32(v[1][0][2] * 16.f, v[1][0][3] * 16.f, t, true);
                        t = __builtin_amdgcn_cvt_pk_fp8_f32(v[1][1][0] * 16.f, v[1][1][1] * 16.f, 0u, false); o.w = __builtin_amdgcn_cvt_pk_fp8_f32(v[1][1][2] * 16.f, v[1][1][3] * 16.f, t, true);
                        h4[0] = o; }
                } else if (P4_SCR_BF16) {
                    if (br > 0) { const u32x4 a = h4[0], b = h4[512];
                        v[0][0] += (f32x4){bflo(a.x), bfhi(a.x), bflo(a.y), bfhi(a.y)}; v[0][1] += (f32x4){bflo(a.z), bfhi(a.z), bflo(a.w), bfhi(a.w)};
                        v[1][0] += (f32x4){bflo(b.x), bfhi(b.x), bflo(b.y), bfhi(b.y)}; v[1][1] += (f32x4){bflo(b.z), bfhi(b.z), bflo(b.w), bfhi(b.w)}; }
                    if (br < 2) { u32x4 a, b; a.x = pk2(v[0][0][0], v[0][0][1]); a.y = pk2(v[0][0][2], v[0][0][3]); a.z = pk2(v[0][1][0], v[0][1][1]); a.w = pk2(v[0][1][2], v[0][1][3]);
                        b.x = pk2(v[1][0][0], v[1][0][1]); b.y = pk2(v[1][0][2], v[1][0][3]); b.z = pk2(v[1][1][0], v[1][1][1]); b.w = pk2(v[1][1][2], v[1][1][3]); h4[0] = a; h4[512] = b; }
                } else {
                if (br > 0) { v[0][0] += s4[0]; v[0][1] += s4[512]; v[1][0] += s4[1024]; v[1][1] += s4[1536]; }
                if (br < 2) { s4[0] = v[0][0]; s4[512] = v[0][1]; s4[1024] = v[1][0]; s4[1536] = v[1][1]; } }
                if (P4_SMALL_FIRST ? br != 0 : br < 2) {}
                else { u32x4 w0, w1; w0.x = pk2(v[0][0][0], v[0][0][1]); w0.y = pk2(v[0][0][2], v[0][0][3]); w0.z = pk2(v[0][1][0], v[0][1][1]); w0.w = pk2(v[0][1][2], v[0][1][3]);
                    w1.x = pk2(v[1][0][0], v[1][0][1]); w1.y = pk2(v[1][0][2], v[1][0][3]); w1.z = pk2(v[1][1][0], v[1][1][1]); w1.w = pk2(v[1][1][2], v[1][1][3]);
                    *(u32x4*)(merged + row * D + cw) = w0; *(u32x4*)(merged + row * D + cw + 8) = w1; } }
    }
#endif
};

struct SchedP5 {
    static constexpr bool SIDE_FIRST = false;
    __device__ __forceinline__ size_t kstep_a() const { return 128; }
    __device__ __forceinline__ size_t kstep_b() const { return 128; }
    __device__ __forceinline__ bool side_due(int) const { return false; } __device__ __forceinline__ void side() const {}
    static constexpr bool GATHER = false, FP8 = false; static constexpr int SCALE_B = 0x7f7f7f7f;
    int lda, ldb, G, c; const char *A, *Bt;
    __device__ __forceinline__ bool next(int i, Unit& u) const { const int L = i * G + c; if (L >= 512) return false; pg8::tile_of(L, 64, 8, u.pm, u.pn); u.aux = 0; return true; }
    __device__ __forceinline__ const char* a_base(const Unit& u) const { return A + (size_t)u.pm * 256 * D * 2; }
    __device__ __forceinline__ const char* b_base(const Unit& u) const { return Bt + (size_t)u.pn * 256 * D * 2; }
    __device__ __forceinline__ int nt(const Unit&) const { return D / 64; }
    __device__ __forceinline__ unsigned gather(const Unit&, int, int) const { return 0u; }
};
struct EpiP5 {
    static constexpr bool PROBE_TWICE = (MK_EPI_TWICE == 5);
    static constexpr int MODE = 0;
    const float* x; float* out; bf16_t* h1b;
    struct Pre {}; __device__ __forceinline__ Pre prefetch(const Unit&, int, int) const { return Pre{}; }
    __device__ __forceinline__ void operator()(const f32x4 (&acc)[2][2][4][2], const Unit& u, int wr, int wc, int fr, int fq, const Pre&) const {
        const int row0 = u.pm * 256 + wr * 64 + fr, col0 = u.pn * 256 + wc * 32 + 4 * fq;
#pragma unroll
        for (int ai = 0; ai < 2; ++ai) { f32x4 t[4][2][2];
#pragma unroll
            for (int m = 0; m < 4; ++m) { const size_t off = (size_t)(row0 + ai * 128 + m * 16) * D + col0;
#pragma unroll
                for (int bj = 0; bj < 2; ++bj)
#pragma unroll
                    for (int n = 0; n < 2; ++n) t[m][bj][n] = *(const f32x4*)(x + off + bj * 128 + n * 16); }
            __builtin_amdgcn_sched_barrier(0);
#pragma unroll
            for (int m = 0; m < 4; ++m) { const size_t off = (size_t)(row0 + ai * 128 + m * 16) * D + col0;
#pragma unroll
                for (int bj = 0; bj < 2; ++bj)
#pragma unroll
                    for (int n = 0; n < 2; ++n) { const f32x4 v = t[m][bj][n] + acc[ai][bj][m][n];
                        if (H1_BF16) { u32x2 o; o.x = pk2(v[0], v[1]); o.y = pk2(v[2], v[3]); *(u32x2*)(h1b + off + bj * 128 + n * 16) = o; }
                        else *(f32x4*)(out + off + bj * 128 + n * 16) = v; } }
        }
    }
};

__device__ __forceinline__ f32x4 ld4_bf16(const bf16_t* p) { const u32x2 v = *(const u32x2*)p; return (f32x4){bflo(v.x), bfhi(v.x), bflo(v.y), bfhi(v.y)}; }
#define P6_LOAD(rowoff, coloff) (H1_BF16 ? ld4_bf16(gsrcb + (size_t)(rowoff) * D + (coloff)) : *(const f32x4*)(gsrc + (size_t)(rowoff) * D + (coloff)))
__device__ __forceinline__ void p6_router(const Frame& F, const bool dry = false) {
    LAS float* part = (LAS float*)F.lds;
    LAS float* ssp = (LAS float*)(F.lds + 32768);
    LAS float* lg = (LAS float*)(F.lds + 33792);
    LAS float* rstd = (LAS float*)(F.lds + 38144);
    LAS int* lcnt = (LAS int*)(F.lds + 38400);
    LAS int* lbase = (LAS int*)(F.lds + 38656);
    const int w = F.wave, lane = F.lane, r = lane & 31, h = lane >> 5, tid = F.tid;
    for (int grp = F.bid; grp < NTOK / 32; grp += F.G) {
        const int row0 = grp * 32;
        float ss = 0.f;
        f32x16 acc;
#pragma unroll
        for (int i = 0; i < 16; ++i) acc[i] = 0.f;
        LAS float* tile = (LAS float*)(F.lds + 40960 + w * 8704);
        const float* gsrc = F.out + (size_t)(row0 + (lane >> 4)) * D + 256 * w + 4 * (lane & 15); const bf16_t* gsrcb = F.h1b + (size_t)(row0 + (lane >> 4)) * D + 256 * w + 4 * (lane & 15);
        LAS float* tw_ = tile + (lane >> 4) * 68 + 4 * (lane & 15); const LAS float* tr_ = tile + r * 68 + 8 * h;
        const bf16_t* wph = F.wrh + (size_t)r * D + 256 * w + 8 * h; const bf16_t* wpl = F.wrl + (size_t)r * D + 256 * w + 8 * h;
        f32x4 pre[8]; bf16x8 wh[4], wl[4], nh[4], nl[4];
#pragma unroll
        for (int j = 0; j < 8; ++j) pre[j] = P6_LOAD(4 * j, 0);
#pragma unroll
        for (int k = 0; k < 4; ++k) { wh[k] = *(const bf16x8*)(wph + 16 * k); wl[k] = *(const bf16x8*)(wpl + 16 * k); }
#pragma unroll 1
        for (int q = 0; q < 4; ++q) {
#pragma unroll
            for (int j = 0; j < 8; ++j) *(LAS f32x4*)(tw_ + (4 * j) * 68) = pre[j];
            if (q < 3) {
#pragma unroll
                for (int j = 0; j < 8; ++j) pre[j] = P6_LOAD(4 * j, 64 * (q + 1));
#pragma unroll
                for (int k = 0; k < 4; ++k) { nh[k] = *(const bf16x8*)(wph + 64 * (q + 1) + 16 * k); nl[k] = *(const bf16x8*)(wpl + 64 * (q + 1) + 16 * k); } }
            LDS_WAIT();
            __builtin_amdgcn_sched_barrier(0);
#pragma unroll
            for (int k = 0; k < 4; ++k) { const f32x4 xa = *(const LAS f32x4*)(tr_ + 16 * k), xb = *(const LAS f32x4*)(tr_ + 16 * k + 4);
                ss += (xa.x * xa.x + xa.y * xa.y) + (xa.z * xa.z + xa.w * xa.w) + (xb.x * xb.x + xb.y * xb.y) + (xb.z * xb.z + xb.w * xb.w);
                u32x4 ph, pl; ph.x = pk2(xa.x, xa.y); ph.y = pk2(xa.z, xa.w); ph.z = pk2(xb.x, xb.y); ph.w = pk2(xb.z, xb.w);
                pl.x = pk2(xa.x - bflo(ph.x), xa.y - bfhi(ph.x)); pl.y = pk2(xa.z - bflo(ph.y), xa.w - bfhi(ph.y)); pl.z = pk2(xb.x - bflo(ph.z), xb.y - bfhi(ph.z)); pl.w = pk2(xb.z - bflo(ph.w), xb.w - bfhi(ph.w));
                const bf16x8 xh = __builtin_bit_cast(bf16x8, ph), xl = __builtin_bit_cast(bf16x8, pl);
                acc = __builtin_amdgcn_mfma_f32_32x32x16_bf16(xh, wh[k], acc, 0, 0, 0); acc = __builtin_amdgcn_mfma_f32_32x32x16_bf16(xl, wh[k], acc, 0, 0, 0); acc = __builtin_amdgcn_mfma_f32_32x32x16_bf16(xh, wl[k], acc, 0, 0, 0); }
            LDS_WAIT();
            __builtin_amdgcn_sched_barrier(0);
            if (q < 3) {
#pragma unroll
                for (int k = 0; k < 4; ++k) { wh[k] = nh[k]; wl[k] = nl[k]; } }
        }
        ss += __shfl_xor(ss, 32);
        if (tid < 32) lcnt[tid] = 0;
        if (h == 0) ssp[w * 32 + r] = ss;
#pragma unroll
        for (int i = 0; i < 16; ++i) part[(w * 32 + (i & 3) + 8 * (i >> 2) + 4 * h) * 32 + r] = acc[i];
        __syncthreads();
        {
            const int row = tid >> 4, e0 = (tid & 15) * 2; float s0 = 0.f, s1 = 0.f, q = 0.f;
#pragma unroll
            for (int k = 0; k < 8; ++k) { s0 += part[(k * 32 + row) * 32 + e0]; s1 += part[(k * 32 + row) * 32 + e0 + 1]; q += ssp[k * 32 + row]; }
            const float rs = __builtin_amdgcn_rsqf(q * (1.f / D) + NORM_EPS);
            lg[row * 33 + e0] = s0 * rs + F.b_r[e0]; lg[row * 33 + e0 + 1] = s1 * rs + F.b_r[e0 + 1];
            if ((tid & 15) == 0) rstd[row] = rs;
        }
        __syncthreads();
        if (!dry) {
            LAS int* sel_e = (LAS int*)(F.lds + 38912); LAS float* sel_l = (LAS float*)(F.lds + 39424); LAS int* sel_r = (LAS int*)(F.lds + 39936);
            { const int row = tid >> 4, e0 = (tid & 15) * 2; const float va = lg[row * 33 + e0], vb = lg[row * 33 + e0 + 1]; int ra = 0, rb = 0;
#pragma unroll 8
              for (int e2 = 0; e2 < NE; ++e2) { const float v2 = lg[row * 33 + e2]; ra += (v2 > va || (v2 == va && e2 < e0)) ? 1 : 0; rb += (v2 > vb || (v2 == vb && e2 < e0 + 1)) ? 1 : 0; }
              if (ra < 4) { sel_e[row * 4 + ra] = e0; sel_l[row * 4 + ra] = va; }
              if (rb < 4) { sel_e[row * 4 + rb] = e0 + 1; sel_l[row * 4 + rb] = vb; } }
            __syncthreads();
            if (tid < 128) sel_r[tid] = __hip_atomic_fetch_add(&lcnt[sel_e[tid]], 1, __ATOMIC_RELAXED, __HIP_MEMORY_SCOPE_WORKGROUP);
            __syncthreads();
            if (tid < 32) { const int c = lcnt[tid]; lbase[tid] = c ? (int)atomicAdd(F.ctl + CW_CNT + 64 * tid, (unsigned)c) : 0; }
            __syncthreads();
            if (tid < 128) { const int row = tid >> 2, k = tid & 3, e = sel_e[tid], t = row0 + row; const float l0 = sel_l[row * 4];
                const float e1 = __expf(sel_l[row * 4 + 1] - l0), e2 = __expf(sel_l[row * 4 + 2] - l0), e3 = __expf(sel_l[row * 4 + 3] - l0), inv = 1.0f / (1.0f + e1 + e2 + e3);
                const float wk = (k == 0 ? 1.0f : (k == 1 ? e1 : (k == 2 ? e2 : e3))) * inv; const int rank = lbase[e] + sel_r[tid];
                F.list[(size_t)e * CAP + rank] = t; F.er[t * 4 + k] = ((unsigned)e << 16) | (unsigned)rank; F.tw[t * 4 + k] = wk; ((LAS int*)(F.lds + 40448))[tid] = (e << 16) | rank; }
            if (XN2_PREGATHER) __syncthreads();
        }
        {
            const f32x4 g = *(const f32x4*)(F.g2 + 256 * w + 4 * lane); const float* xp = F.out + (size_t)row0 * D + 256 * w + 4 * lane; const bf16_t* xpb = F.h1b + (size_t)row0 * D + 256 * w + 4 * lane;
            unsigned char* op8 = (unsigned char*)F.xn2 + (size_t)row0 * D + 256 * w + 4 * lane; bf16_t* op = F.xn2 + (size_t)row0 * D + 256 * w + 4 * lane;
#pragma unroll 32
            for (int j = 0; j < 32; ++j) { const f32x4 xv = H1_BF16 ? ld4_bf16(xpb + (size_t)j * D) : *(const f32x4*)(xp + (size_t)j * D); const float rs = rstd[j];
                if constexpr (MOE_FP8) { const unsigned t = __builtin_amdgcn_cvt_pk_fp8_f32(xv.x * rs * g.x, xv.y * rs * g.y, 0u, false); const unsigned wq = __builtin_amdgcn_cvt_pk_fp8_f32(xv.z * rs * g.z, xv.w * rs * g.w, t, true);
                    if (XN2_PREGATHER) {
#pragma unroll
                        for (int k = 0; k < 4; ++k) { const int sl = ((const LAS int*)(F.lds + 40448))[j * 4 + k];
                            *(unsigned*)(F.xg + ((size_t)((sl >> 16) * 16 + 2 * w + (lane >> 5)) * CAP + (sl & 0xffff)) * 128 + ((4 * lane) & 127)) = wq; } }
                    else *(unsigned*)(op8 + (size_t)j * D) = wq; }
                else { u32x2 o; o.x = pk2(xv.x * rs * g.x, xv.y * rs * g.y); o.y = pk2(xv.z * rs * g.z, xv.w * rs * g.w); *(u32x2*)(op + (size_t)j * D) = o; } }
        }
        __syncthreads();
    }
}

__device__ __forceinline__ void moe_tables(const Frame& F) {
    LAS int* cntL = (LAS int*)(F.lds + L_CNT); LAS int* mbst = (LAS int*)(F.lds + L_MBST); LAS int* nmbp = (LAS int*)(F.lds + L_NMB); LAS int* mbe = (LAS int*)(F.lds + L_MBE); LAS int* mbr0 = (LAS int*)(F.lds + L_MBR0);
    __syncthreads();
    if (F.wave == 0) {
        const int lane = F.lane, c = lane < NE ? (int)F.ctl[CW_CNT + 64 * lane] : 0, n = (c + 255) >> 8; int incl = n;
#pragma unroll
        for (int o = 1; o < 32; o <<= 1) { const int v = __shfl_up(incl, o); if (lane >= o) incl += v; }
        if (lane < NE) { cntL[lane] = c; mbst[lane] = incl - n; }
        if (lane == NE - 1) { mbst[NE] = incl; nmbp[0] = incl; }
    }
    __syncthreads();
    const int nmb = nmbp[0];
    for (int t = F.tid; t < nmb; t += 512) {
        int e = 0;
#pragma unroll 8
        for (int e2 = 1; e2 < NE; ++e2) e += (mbst[e2] <= t) ? 1 : 0;
        mbe[t] = e; mbr0[t] = 256 * (t - mbst[e]); }
    __syncthreads();
}

struct SchedP7 {
    static constexpr bool SIDE_FIRST = false;
    __device__ __forceinline__ size_t kstep_a() const { return XN2_PREGATHER ? (size_t)CAP * 128 : 128; }
    __device__ __forceinline__ bool side_due(int) const { return false; } __device__ __forceinline__ void side() const {}
    static constexpr bool GATHER = !XN2_PREGATHER, FP8 = MOE_FP8 != 0; static constexpr int SCALE_B = 0x79797979;
    int lda, ldb, G, c, nmb; const char *xn2, *WupT; const int* list; LAS unsigned char* lds;
    __device__ __forceinline__ bool next(int i, Unit& u) const { const int L = i * G + c; if (L >= nmb * 16) return false; pg8::tile_of(L, nmb, 16, u.pm, u.pn, MOE_WGM); u.aux = ((const LAS int*)(lds + L_MBE))[u.pm]; return true; }
    __device__ __forceinline__ const char* a_base(const Unit& u) const { return XN2_PREGATHER ? xn2 + ((size_t)(u.aux * 16) * CAP + ((const LAS int*)(lds + L_MBR0))[u.pm]) * 128 : xn2; }
    __device__ __forceinline__ size_t kstep_b() const { return MOE_W_KTILE_MAJOR ? (size_t)2 * DFF * 128 : 128; }
    __device__ __forceinline__ const char* b_base(const Unit& u) const { return MOE_W_KTILE_MAJOR ? WupT + (size_t)u.aux * 2 * DFF * D + (size_t)u.pn * 256 * 128 : WupT + ((size_t)u.aux * 2 * DFF + (size_t)u.pn * 256) * D * MOE_EB; }
    __device__ __forceinline__ int nt(const Unit&) const { return D * MOE_EB / 128; }
    __device__ __forceinline__ unsigned gather(const Unit& u, int R, int C2) const {
        const int r0 = ((const LAS int*)(lds + L_MBR0))[u.pm], cnt = ((const LAS int*)(lds + L_CNT))[u.aux], row = r0 + R;
        const int tok = row < cnt ? list[(size_t)u.aux * CAP + row] : 0;
        return (unsigned)tok * (unsigned)(D * MOE_EB) + (unsigned)C2;
    }
};
struct EpiP7 {
    static constexpr bool PROBE_TWICE = (MK_EPI_TWICE == 7);
    static constexpr int MODE = 1;
    const float* b_up; bf16_t* act;
    struct Pre { f32x4 bv[2][2]; };
    __device__ __forceinline__ Pre prefetch(const Unit& u, int wc, int fq) const { Pre p; const int cw = u.pn * 256 + wc * 64 + fq * 16;
#pragma unroll
        for (int bj = 0; bj < 2; ++bj)
#pragma unroll
            for (int n = 0; n < 2; ++n) p.bv[bj][n] = *(const f32x4*)(b_up + (size_t)u.aux * 2 * DFF + cw + bj * 8 + n * 4);
        return p; }
    __device__ __forceinline__ void operator()(const f32x4 (&acc)[2][2][4][2], const Unit& u, int wr, int wc, int fr, int fq, const Pre& pre) const {
        const int row0 = u.pm * 256 + wr * 64 + fr, cw = u.pn * 256 + wc * 64 + fq * 16;
        const f32x4 (&bv)[2][2] = pre.bv;
#pragma unroll
        for (int ai = 0; ai < 2; ++ai)
#pragma unroll
            for (int m = 0; m < 4; ++m) { float a8[8];
#pragma unroll
                for (int bj = 0; bj < 2; ++bj)
#pragma unroll
                    for (int n = 0; n < 2; ++n) { const f32x4 v = acc[ai][bj][m][n] + bv[bj][n];
                        const f32x2 g = {fminf(v[0], 7.0f), fminf(v[2], 7.0f)}, up = {fminf(fmaxf(v[1], -7.0f), 7.0f), fminf(fmaxf(v[3], -7.0f), 7.0f)};
                        const f32x2 t = g * (f32x2){-1.702f * LOG2E, -1.702f * LOG2E};
                        const f32x2 d = (f32x2){__builtin_amdgcn_exp2f(t.x), __builtin_amdgcn_exp2f(t.y)} + (f32x2){1.0f, 1.0f};
                        const f32x2 o = g * (f32x2){__builtin_amdgcn_rcpf(d.x), __builtin_amdgcn_rcpf(d.y)} * (up + (f32x2){1.0f, 1.0f});
                        a8[bj * 4 + n * 2] = o.x; a8[bj * 4 + n * 2 + 1] = o.y; }
                if constexpr (MOE_FP8) { u32x2 w; unsigned t;
                    t = __builtin_amdgcn_cvt_pk_fp8_f32(a8[0], a8[1], 0u, false); w.x = __builtin_amdgcn_cvt_pk_fp8_f32(a8[2], a8[3], t, true);
                    t = __builtin_amdgcn_cvt_pk_fp8_f32(a8[4], a8[5], 0u, false); w.y = __builtin_amdgcn_cvt_pk_fp8_f32(a8[6], a8[7], t, true);
                    if (ACT_KTILE_MAJOR) *(u32x2*)((unsigned char*)act + ((size_t)u.pn * NSLOT + (row0 + ai * 128 + m * 16)) * 128 + ((cw >> 1) & 127)) = w;
                    else *(u32x2*)((unsigned char*)act + (size_t)(row0 + ai * 128 + m * 16) * DFF + (cw >> 1)) = w; }
                else { u32x4 w; w.x = pk2(a8[0], a8[1]); w.y = pk2(a8[2], a8[3]); w.z = pk2(a8[4], a8[5]); w.w = pk2(a8[6], a8[7]);
                    *(u32x4*)(act + (size_t)(row0 + ai * 128 + m * 16) * DFF + (cw >> 1)) = w; } }
    }
};

struct SchedP8 {
    static constexpr bool SIDE_FIRST = false;
    __device__ __forceinline__ bool side_due(int) const { return false; } __device__ __forceinline__ void side() const {}
    static constexpr bool GATHER = false, FP8 = MOE_FP8 != 0; static constexpr int SCALE_B = 0x79797979;
    int lda, ldb, G, c, nmb; const char *act, *WdnT; LAS unsigned char* lds;
    __device__ __forceinline__ bool next(int i, Unit& u) const { const int L = i * G + c; if (L >= nmb * 8) return false; pg8::tile_of(L, nmb, 8, u.pm, u.pn, MOE_WGM_DN); u.aux = ((const LAS int*)(lds + L_MBE))[u.pm]; return true; }
    __device__ __forceinline__ size_t kstep_a() const { return ACT_KTILE_MAJOR ? (size_t)NSLOT * 128 : 128; }
    __device__ __forceinline__ const char* a_base(const Unit& u) const { return ACT_KTILE_MAJOR ? act + (size_t)u.pm * 256 * 128 : act + (size_t)u.pm * 256 * DFF * MOE_EB; }
    __device__ __forceinline__ size_t kstep_b() const { return MOE_W_KTILE_MAJOR ? (size_t)D * 128 : 128; }
    __device__ __forceinline__ const char* b_base(const Unit& u) const { return MOE_W_KTILE_MAJOR ? WdnT + (size_t)u.aux * D * DFF + (size_t)u.pn * 256 * 128 : WdnT + ((size_t)u.aux * D + (size_t)u.pn * 256) * DFF * MOE_EB; }
    __device__ __forceinline__ int nt(const Unit&) const { return DFF * MOE_EB / 128; }
    __device__ __forceinline__ unsigned gather(const Unit&, int, int) const { return 0u; }
};
struct EpiP8 {
    static constexpr bool PROBE_TWICE = (MK_EPI_TWICE == 8);
    static constexpr int MODE = 1;
    const float* b_dn; bf16_t* ybuf;
    struct Pre { f32x4 bv[2][2]; };
    __device__ __forceinline__ Pre prefetch(const Unit& u, int wc, int fq) const { Pre p; const int cw = u.pn * 256 + wc * 64 + fq * 16;
#pragma unroll
        for (int bj = 0; bj < 2; ++bj)
#pragma unroll
            for (int n = 0; n < 2; ++n) p.bv[bj][n] = *(const f32x4*)(b_dn + (size_t)u.aux * D + cw + bj * 8 + n * 4);
        return p; }
    __device__ __forceinline__ void operator()(const f32x4 (&acc)[2][2][4][2], const Unit& u, int wr, int wc, int fr, int fq, const Pre& pre) const {
        const int row0 = u.pm * 256 + wr * 64 + fr, cw = u.pn * 256 + wc * 64 + fq * 16;
        const f32x4 (&bv)[2][2] = pre.bv;
#pragma unroll
        for (int ai = 0; ai < 2; ++ai)
#pragma unroll
            for (int m = 0; m < 4; ++m) { bf16_t* rowp = ybuf + (size_t)(row0 + ai * 128 + m * 16) * D + cw;
                if (YBUF_FP8) { u32x4 w; unsigned t; const f32x4 a0 = acc[ai][0][m][0] + bv[0][0], a1 = acc[ai][0][m][1] + bv[0][1], a2 = acc[ai][1][m][0] + bv[1][0], a3 = acc[ai][1][m][1] + bv[1][1];
                    t = __builtin_amdgcn_cvt_pk_fp8_f32(a0[0], a0[1], 0u, false); w.x = __builtin_amdgcn_cvt_pk_fp8_f32(a0[2], a0[3], t, true);
                    t = __builtin_amdgcn_cvt_pk_fp8_f32(a1[0], a1[1], 0u, false); w.y = __builtin_amdgcn_cvt_pk_fp8_f32(a1[2], a1[3], t, true);
                    t = __builtin_amdgcn_cvt_pk_fp8_f32(a2[0], a2[1], 0u, false); w.z = __builtin_amdgcn_cvt_pk_fp8_f32(a2[2], a2[3], t, true);
                    t = __builtin_amdgcn_cvt_pk_fp8_f32(a3[0], a3[1], 0u, false); w.w = __builtin_amdgcn_cvt_pk_fp8_f32(a3[2], a3[3], t, true);
                    *(u32x4*)((unsigned char*)ybuf + (size_t)(row0 + ai * 128 + m * 16) * D + cw) = w; }
                else {
#pragma unroll
                for (int bj = 0; bj < 2; ++bj) { const f32x4 v0 = acc[ai][bj][m][0] + bv[bj][0], v1 = acc[ai][bj][m][1] + bv[bj][1];
                    u32x4 w; w.x = pk2(v0[0], v0[1]); w.y = pk2(v0[2], v0[3]); w.z = pk2(v1[0], v1[1]); w.w = pk2(v1[2], v1[3]);
                    *(u32x4*)(rowp + bj * 8) = w; } } }
    }
};

__device__ __forceinline__ void p9_combine(const Frame& F, const bool dry = false) {
    const LAS int* mbst = (const LAS int*)(F.lds + L_MBST);
    const int gw = F.bid * 8 + F.wave, NGW = F.G * 8, lane = F.lane;
    for (int t = gw; t < NTOK; t += NGW) {
        const bf16_t* yp[4]; const unsigned char* yp8[4]; float wk[4];
#pragma unroll
        for (int k = 0; k < 4; ++k) { const unsigned erv = F.er[t * 4 + k]; const int e = (int)(erv >> 16), rank = (int)(erv & 0xffffu);
            yp[k] = F.ybuf + (size_t)(256 * mbst[e] + rank) * D + lane * 8; yp8[k] = (const unsigned char*)F.ybuf + (size_t)(256 * mbst[e] + rank) * D + lane * 8; wk[k] = F.tw[t * 4 + k]; }
        float* op = F.out + (size_t)t * D + lane * 8; const bf16_t* hp = F.h1b + (size_t)t * D + lane * 8;
#pragma unroll
        for (int st = 0; st < 4; ++st) {
            f32x4 o0, o1;
            if (H1_BF16) { const u32x4 hv = *(const u32x4*)(hp + 512 * st); o0 = (f32x4){bflo(hv.x), bfhi(hv.x), bflo(hv.y), bfhi(hv.y)}; o1 = (f32x4){bflo(hv.z), bfhi(hv.z), bflo(hv.w), bfhi(hv.w)}; }
            else { o0 = *(const f32x4*)(op + 512 * st); o1 = *(const f32x4*)(op + 512 * st + 4); }
#pragma unroll
            for (int k = 0; k < 4; ++k) { const float wv = wk[k];
                if (YBUF_FP8) { const u32x2 y = *(const u32x2*)(yp8[k] + 512 * st);
                    const f32x2 a = __builtin_amdgcn_cvt_pk_f32_fp8((int)y.x, false), b = __builtin_amdgcn_cvt_pk_f32_fp8((int)y.x, true), c = __builtin_amdgcn_cvt_pk_f32_fp8((int)y.y, false), d = __builtin_amdgcn_cvt_pk_f32_fp8((int)y.y, true);
                    o0 += wv * (f32x4){a.x, a.y, b.x, b.y}; o1 += wv * (f32x4){c.x, c.y, d.x, d.y}; }
                else { const u32x4 y = *(const u32x4*)(yp[k] + 512 * st);
                    o0 += wv * (f32x4){bflo(y.x), bfhi(y.x), bflo(y.y), bfhi(y.y)}; o1 += wv * (f32x4){bflo(y.z), bfhi(y.z), bflo(y.w), bfhi(y.w)}; } }
            if (dry) { asm volatile("" :: "v"(o0), "v"(o1)); o0 = *(const f32x4*)(op + 512 * st); o1 = *(const f32x4*)(op + 512 * st + 4); asm volatile("" : "+v"(o0), "+v"(o1)); }
            __builtin_nontemporal_store(o0, (f32x4*)(op + 512 * st)); __builtin_nontemporal_store(o1, (f32x4*)(op + 512 * st + 4));
        }
    }
}


#ifndef MK_NAIVE
#define MK_NAIVE 0
#endif
#ifndef MK_FAST
#define MK_FAST 0x3ff
#endif
#if MK_NAIVE
namespace nv {
__device__ __forceinline__ float sigm(float x) { return 1.0f / (1.0f + __expf(-x)); }
__global__ void __launch_bounds__(256) k_rms(const float* x, const float* g, bf16_t* o) {
    __shared__ float red[256];
    const int row = blockIdx.x, tid = threadIdx.x; const float* xr = x + (size_t)row * D;
    float s = 0.f; for (int i = tid; i < D; i += 256) s += xr[i] * xr[i];
    red[tid] = s; __syncthreads();
    for (int o2 = 128; o2 > 0; o2 >>= 1) { if (tid < o2) red[tid] += red[tid + o2]; __syncthreads(); }
    const float r = 1.0f / sqrtf(red[0] / D + NORM_EPS);
    for (int i = tid; i < D; i += 256) o[(size_t)row * D + i] = f2bf(xr[i] * r * g[i]);
}
template <class P> __global__ void __launch_bounds__(256) k_gemm(P p) {
    __shared__ float As[16][65], Bs[16][65];
    const int tid = threadIdx.x, tx = tid & 15, ty = tid >> 4, z = blockIdx.z;
    const int M = p.rows(z), m0 = blockIdx.y * 64, n0 = blockIdx.x * 64;
    if (m0 >= M) return;
    const int base = p.base(z);
    float acc[4][4];
#pragma unroll
    for (int i = 0; i < 4; ++i)
#pragma unroll
        for (int j = 0; j < 4; ++j) acc[i][j] = 0.f;
    for (int k0 = 0; k0 < p.K; k0 += 16) {
#pragma unroll
        for (int i = 0; i < 4; ++i) { const int idx = tid + 256 * i, m = idx >> 4, k = idx & 15; As[k][m] = (m0 + m < M) ? p.a(z, base, m0 + m, k0 + k) : 0.f; }
#pragma unroll
        for (int i = 0; i < 4; ++i) { const int idx = tid + 256 * i, k = idx >> 6, n = idx & 63; Bs[k][n] = p.b(z, k0 + k, n0 + n); }
        __syncthreads();
#pragma unroll
        for (int k = 0; k < 16; ++k) { float a[4], b[4];
#pragma unroll
            for (int i = 0; i < 4; ++i) { a[i] = As[k][ty * 4 + i]; b[i] = Bs[k][tx * 4 + i]; }
#pragma unroll
            for (int i = 0; i < 4; ++i)
#pragma unroll
                for (int j = 0; j < 4; ++j) acc[i][j] += a[i] * b[j]; }
        __syncthreads();
    }
#pragma unroll
    for (int i = 0; i < 4; ++i) { const int m = m0 + ty * 4 + i; if (m < M) p.epi(z, base, m, n0 + tx * 4, acc[i][0], acc[i][1], acc[i][2], acc[i][3]); }
}
struct PIn { const bf16_t* xn; const float* w; const float* b_gate; bf16_t* proj; int K, pad;
    __device__ int rows(int) const { return NTOK; } __device__ int base(int) const { return 0; }
    __device__ float a(int, int, int m, int k) const { return bf2f(xn[(size_t)m * D + k]); }
    __device__ float b(int, int k, int n) const { return w[(size_t)k * IN_W + n]; }
    __device__ void epi(int, int, int m, int n0, float v0, float v1, float v2, float v3) const { float v[4] = {v0, v1, v2, v3};
#pragma unroll
        for (int j = 0; j < 4; ++j) { const int n = n0 + j; float y = v[j]; if (n >= OFF_GATE) y = sigm(y + b_gate[n - OFF_GATE]); proj[(size_t)m * IN_W + n] = f2bf(y); } } };
struct PMkv { const bf16_t* mn; const float* w; bf16_t* kvraw; int K, pad;
    __device__ int rows(int) const { return NMEMROW; } __device__ int base(int) const { return 0; }
    __device__ float a(int, int, int m, int k) const { return bf2f(mn[(size_t)m * D + k]); }
    __device__ float b(int, int k, int n) const { return w[(size_t)k * 1024 + n]; }
    __device__ void epi(int, int, int m, int n0, float v0, float v1, float v2, float v3) const { float v[4] = {v0, v1, v2, v3};
#pragma unroll
        for (int j = 0; j < 4; ++j) kvraw[(size_t)m * 1024 + n0 + j] = f2bf(v[j]); } };
struct PBr { const float* af; const bf16_t* ab; int lda, aoff; const float* w; const bf16_t* proj; float* tmp; bf16_t* merged; int br, K;
    __device__ int rows(int) const { return NTOK; } __device__ int base(int) const { return 0; }
    __device__ float a(int, int, int m, int k) const { return af ? af[(size_t)m * lda + aoff + k] : bf2f(ab[(size_t)m * lda + aoff + k]); }
    __device__ float b(int, int k, int n) const { return w[(size_t)k * D + n]; }
    __device__ void epi(int, int, int m, int n0, float v0, float v1, float v2, float v3) const { float v[4] = {v0, v1, v2, v3};
#pragma unroll
        for (int j = 0; j < 4; ++j) { const int n = n0 + j; float y = v[j] * bf2f(proj[(size_t)m * IN_W + OFF_GATE + br * D + n]);
            if (br > 0) y += tmp[(size_t)m * D + n];
            if (br < 2) tmp[(size_t)m * D + n] = y; else merged[(size_t)m * D + n] = f2bf(y); } } };
struct POut { const bf16_t* merged; const float* w; const float* x; float* out; int K, pad;
    __device__ int rows(int) const { return NTOK; } __device__ int base(int) const { return 0; }
    __device__ float a(int, int, int m, int k) const { return bf2f(merged[(size_t)m * D + k]); }
    __device__ float b(int, int k, int n) const { return w[(size_t)k * D + n]; }
    __device__ void epi(int, int, int m, int n0, float v0, float v1, float v2, float v3) const { float v[4] = {v0, v1, v2, v3};
#pragma unroll
        for (int j = 0; j < 4; ++j) out[(size_t)m * D + n0 + j] = x[(size_t)m * D + n0 + j] + v[j]; } };
__device__ __forceinline__ int mb_base(const unsigned* ctl, int e) { int mb = 0; for (int i = 0; i < e; ++i) mb += ((int)ctl[CW_CNT + 64 * i] + 255) >> 8; return mb * 256; }
struct PUp { const bf16_t* xn2; const int* list; const unsigned* ctl; const float* w; const float* bias; bf16_t* act; int K, pad;
    __device__ int rows(int z) const { return (int)ctl[CW_CNT + 64 * z]; } __device__ int base(int z) const { return mb_base(ctl, z); }
    __device__ float a(int z, int, int m, int k) const { return bf2f(xn2[(size_t)list[(size_t)z * CAP + m] * D + k]); }
    __device__ float b(int z, int k, int n) const { return w[((size_t)z * D + k) * (2 * DFF) + n]; }
    __device__ void epi(int z, int base, int m, int n0, float v0, float v1, float v2, float v3) const { float v[4] = {v0, v1, v2, v3};
#pragma unroll
        for (int p = 0; p < 2; ++p) { const float g = fminf(v[2 * p] + bias[(size_t)z * 2 * DFF + n0 + 2 * p], 7.0f), u = fminf(fmaxf(v[2 * p + 1] + bias[(size_t)z * 2 * DFF + n0 + 2 * p + 1], -7.0f), 7.0f);
            act[(size_t)(base + m) * DFF + (n0 >> 1) + p] = f2bf(g * sigm(1.702f * g) * (u + 1.0f)); } } };
struct PDn { const bf16_t* act; const unsigned* ctl; const float* w; const float* bias; bf16_t* ybuf; int K, pad;
    __device__ int rows(int z) const { return (int)ctl[CW_CNT + 64 * z]; } __device__ int base(int z) const { return mb_base(ctl, z); }
    __device__ float a(int, int base, int m, int k) const { return bf2f(act[(size_t)(base + m) * DFF + k]); }
    __device__ float b(int z, int k, int n) const { return w[((size_t)z * DFF + k) * D + n]; }
    __device__ void epi(int z, int base, int m, int n0, float v0, float v1, float v2, float v3) const { float v[4] = {v0, v1, v2, v3};
#pragma unroll
        for (int j = 0; j < 4; ++j) ybuf[(size_t)(base + m) * D + n0 + j] = f2bf(v[j] + bias[(size_t)z * D + n0 + j]); } };
__global__ void __launch_bounds__(256) k_heads(const bf16_t* proj, const int* pos, const float* gq, const float* gk, const float* gmq, bf16_t* qn, bf16_t* kn, bf16_t* mqn) {
    const int i = blockIdx.x * 256 + threadIdx.x; if (i >= NTOK * 14) return;
    const int t = i / 14, h = i % 14;
    const bf16_t* src; const float* g; bf16_t* dst; bool rot; float sc;
    if (h < 8) { src = proj + (size_t)t * IN_W + OFF_Q + h * 128; g = gq; dst = qn + (size_t)t * 1024 + h * 128; rot = true; sc = QSCALE; }
    else if (h < 10) { src = proj + (size_t)t * IN_W + OFF_K + (h - 8) * 128; g = gk; dst = kn + (size_t)t * 256 + (h - 8) * 128; rot = true; sc = 1.0f; }
    else { src = proj + (size_t)t * IN_W + OFF_MQ + (h - 10) * 128; g = gmq; dst = mqn + (size_t)t * 512 + (h - 10) * 128; rot = false; sc = QSCALE; }
    float ss = 0.f; for (int d = 0; d < 128; ++d) { const float v = bf2f(src[d]); ss += v * v; }
    const float r = 1.0f / sqrtf(ss / 128.f + NORM_EPS), p = (float)pos[t];
    for (int d = 0; d < 64; ++d) {
        const float y1 = bf2f(src[d]) * r * g[d], y2 = bf2f(src[d + 64]) * r * g[d + 64];
        if (rot) { const float inv_freq = powf(10000.0f, -(float)d * (2.0f / 128.0f)), ang = p * inv_freq, c = cosf(ang), s = sinf(ang);
            dst[d] = f2bf((y1 * c - y2 * s) * sc); dst[d + 64] = f2bf((y2 * c + y1 * s) * sc); }
        else { dst[d] = f2bf(y1 * sc); dst[d + 64] = f2bf(y2 * sc); }
    }
}
__global__ void __launch_bounds__(256) k_memk(const bf16_t* kvraw, const float* gmk, bf16_t* mk, bf16_t* mvT) {
    const int i = blockIdx.x * 256 + threadIdx.x; if (i >= NMEMROW * 4) return;
    const int r = i >> 2, h = i & 3, b = r / MEMLEN, j = r % MEMLEN; const bf16_t* src = kvraw + (size_t)r * 1024 + h * 128;
    float ss = 0.f; for (int d = 0; d < 128; ++d) { const float v = bf2f(src[d]); ss += v * v; }
    const float q = 1.0f / sqrtf(ss / 128.f + NORM_EPS);
    for (int d = 0; d < 128; ++d) { mk[(size_t)r * 512 + h * 128 + d] = f2bf(bf2f(src[d]) * q * gmk[d]); mvT[((size_t)((b * 4 + h) * 128 + d)) * MEMLEN + j] = src[512 + d]; }
}
__global__ void __launch_bounds__(256) k_vT(const bf16_t* proj, bf16_t* vT) {
    const size_t i = (size_t)blockIdx.x * 256 + threadIdx.x; if (i >= (size_t)NTOK * 256) return;
    const int c = (int)(i & 255), t = (int)(i >> 8), b = t / SEQ, s = t % SEQ;
    vT[((size_t)(b * 256 + c)) * SEQ + s] = proj[(size_t)t * IN_W + OFF_V + c];
}
__global__ void __launch_bounds__(256) k_pool(const bf16_t* proj, bf16_t* acat) {
    const size_t i = (size_t)blockIdx.x * 256 + threadIdx.x; if (i >= (size_t)NTOK * 512) return;
    const int c = (int)(i & 511), t = (int)(i >> 9), b = t / SEQ, s = t % SEQ, g = c >> 7, w = 2 << g;
    int lo = s - w / 2, hi = lo + w; lo = lo < 0 ? 0 : lo; hi = hi > SEQ ? SEQ : hi;
    float a = 0.f; for (int j = lo; j < hi; ++j) a += bf2f(proj[(size_t)(b * SEQ + j) * IN_W + OFF_POOL + c]);
    acat[(size_t)t * D + c] = f2bf(a / (float)(hi - lo) - bf2f(proj[(size_t)t * IN_W + OFF_POOL + c]));
}
__global__ void __launch_bounds__(256) k_attn(const bf16_t* qn, const bf16_t* kn, const bf16_t* vT, const bf16_t* mqn, const bf16_t* mk, const bf16_t* mvT, const float* sink, bf16_t* acat) {
    const int wv = blockIdx.x * 4 + (threadIdx.x >> 6), lane = threadIdx.x & 63; if (wv >= NTOK * 12) return;
    const int t = wv / 12, h = wv % 12, b = t / SEQ, s = t % SEQ;
    float q1, q2, m, l, o1 = 0.f, o2 = 0.f;
    if (h < 8) { const int kvh = h >> 2; q1 = bf2f(qn[(size_t)t * 1024 + h * 128 + lane]); q2 = bf2f(qn[(size_t)t * 1024 + h * 128 + 64 + lane]); m = sink[h] * LOG2E; l = 1.0f;
        int lo = s - 128, hi = s + 128; lo = lo < 0 ? 0 : lo; hi = hi > SEQ - 1 ? SEQ - 1 : hi;
        for (int j = lo; j <= hi; ++j) { const bf16_t* kr = kn + (size_t)(b * SEQ + j) * 256 + kvh * 128;
            const float sc = wave_sum(q1 * bf2f(kr[lane]) + q2 * bf2f(kr[64 + lane])), mn = fmaxf(m, sc), al = exp2f(m - mn), p = exp2f(sc - mn);
            l = l * al + p; o1 = o1 * al + p * bf2f(vT[((size_t)((b * 2 + kvh) * 128 + lane)) * SEQ + j]); o2 = o2 * al + p * bf2f(vT[((size_t)((b * 2 + kvh) * 128 + 64 + lane)) * SEQ + j]); m = mn; }
        acat[(size_t)t * D + 512 + h * 128 + lane] = f2bf(o1 / l); acat[(size_t)t * D + 512 + h * 128 + 64 + lane] = f2bf(o2 / l);
    } else { const int hm = h - 8; q1 = bf2f(mqn[(size_t)t * 512 + hm * 128 + lane]); q2 = bf2f(mqn[(size_t)t * 512 + hm * 128 + 64 + lane]); m = -1e30f; l = 0.f;
        for (int j = 0; j < MEMLEN; ++j) { const bf16_t* kr = mk + (size_t)(b * MEMLEN + j) * 512 + hm * 128;
            const float sc = wave_sum(q1 * bf2f(kr[lane]) + q2 * bf2f(kr[64 + lane])), mn = fmaxf(m, sc), al = exp2f(m - mn), p = exp2f(sc - mn);
            l = l * al + p; o1 = o1 * al + p * bf2f(mvT[((size_t)((b * 4 + hm) * 128 + lane)) * MEMLEN + j]); o2 = o2 * al + p * bf2f(mvT[((size_t)((b * 4 + hm) * 128 + 64 + lane)) * MEMLEN + j]); m = mn; }
        acat[(size_t)t * D + 1536 + hm * 128 + lane] = f2bf(o1 / l); acat[(size_t)t * D + 1536 + hm * 128 + 64 + lane] = f2bf(o2 / l);
    }
}
__global__ void __launch_bounds__(256) k_a2(const bf16_t* acat, const float* w_pg, const float* pool_scale, float* a2) {
    const size_t i = (size_t)blockIdx.x * 256 + threadIdx.x; if (i >= (size_t)NTOK * 512) return;
    const int n = (int)(i & 511), t = (int)(i >> 9), g = n >> 7, d = n & 127;
    float a = 0.f; for (int c = 0; c < 128; ++c) a += bf2f(acat[(size_t)t * D + g * 128 + c]) * w_pg[(size_t)(g * 128 + c) * 128 + d];
    a2[(size_t)t * 512 + n] = a * pool_scale[n];
}
__global__ void __launch_bounds__(256) k_router(const float* h1, const float* g2, const float* w_r, const float* b_r, bf16_t* xn2, unsigned* ctl, int* list, unsigned* er, float* tw) {
    const int t = blockIdx.x * 4 + (threadIdx.x >> 6), lane = threadIdx.x & 63; if (t >= NTOK) return;
    const float* hr = h1 + (size_t)t * D;
    float ss = 0.f; for (int j = 0; j < 32; ++j) { const float v = hr[lane + 64 * j]; ss += v * v; }
    const float rs = 1.0f / sqrtf(wave_sum(ss) / D + NORM_EPS);
    float acc[32];
#pragma unroll
    for (int e = 0; e < 32; ++e) acc[e] = 0.f;
    for (int j = 0; j < 32; ++j) { const int k = lane + 64 * j; const float y = hr[k] * rs * g2[k]; xn2[(size_t)t * D + k] = f2bf(y);
        const f32x4* wr = (const f32x4*)(w_r + (size_t)k * 32);
#pragma unroll
        for (int e4 = 0; e4 < 8; ++e4) { const f32x4 w4 = wr[e4]; acc[4 * e4] += y * w4.x; acc[4 * e4 + 1] += y * w4.y; acc[4 * e4 + 2] += y * w4.z; acc[4 * e4 + 3] += y * w4.w; } }
#pragma unroll
    for (int e = 0; e < 32; ++e) acc[e] = wave_sum(acc[e]) + b_r[e];
    int te[4]; float tl[4]; unsigned taken = 0u;
#pragma unroll
    for (int k = 0; k < 4; ++k) { float best = -3.0e38f; int bi = 0;
#pragma unroll
        for (int e = 0; e < 32; ++e) { const bool ok = !((taken >> e) & 1u) && acc[e] > best; best = ok ? acc[e] : best; bi = ok ? e : bi; }
        taken |= 1u << bi; te[k] = bi; tl[k] = best; }
    if (lane == 0) {
        const float e1 = expf(tl[1] - tl[0]), e2 = expf(tl[2] - tl[0]), e3 = expf(tl[3] - tl[0]), inv = 1.0f / (1.0f + e1 + e2 + e3);
        const float w4[4] = {inv, e1 * inv, e2 * inv, e3 * inv};
#pragma unroll
        for (int k = 0; k < 4; ++k) { const unsigned rank = atomicAdd(ctl + CW_CNT + 64 * te[k], 1u); list[(size_t)te[k] * CAP + rank] = t; er[t * 4 + k] = ((unsigned)te[k] << 16) | rank; tw[t * 4 + k] = w4[k]; }
    }
}
__global__ void __launch_bounds__(256) k_combine(const unsigned* ctl, const unsigned* er, const float* tw, const bf16_t* ybuf, float* out) {
    __shared__ int slot[4]; __shared__ float wk[4];
    const int t = blockIdx.x, tid = threadIdx.x;
    if (tid < 4) { const unsigned v = er[t * 4 + tid]; slot[tid] = mb_base(ctl, (int)(v >> 16)) + (int)(v & 0xffffu); wk[tid] = tw[t * 4 + tid]; }
    __syncthreads();
    for (int n = tid; n < D; n += 256) { float a = out[(size_t)t * D + n];
        for (int k = 0; k < 4; ++k) a += wk[k] * bf2f(ybuf[(size_t)slot[k] * D + n]);
        out[(size_t)t * D + n] = a; }
}
}
#endif

constexpr int NPH = 10;
__global__ void __launch_bounds__(512, 2) fwd(Args args) {
    extern __shared__ __attribute__((aligned(16))) unsigned char lds_raw[];
    Frame F;
    F.lds = (LAS unsigned char*)lds_raw; F.tid = threadIdx.x; F.lane = F.tid & 63; F.wave = __builtin_amdgcn_readfirstlane(F.tid >> 6); F.G = gridDim.x; F.bid = blockIdx.x;
    fill_frame(F, args.in, args.out, args.ws);

    for (int u = F.tid; u < (LDS_BYTES - MISC_OFF) / 4; u += 512) ((LAS unsigned*)(F.lds + MISC_OFF))[u] = 0u;
    __syncthreads();
    XcdBarrier bar; bar.bar = F.ctl + CW_BAR; bar.x = 0; bar.st = nullptr;
    if (!MK_SPLIT) bar = xcd_barrier_post(F.ctl + CW_BAR, (volatile LAS unsigned*)(F.lds + MISC_OFF));
    const int lo = args.ph_lo, hi = args.ph_hi;
#ifdef MK_ONLY
#define IN(k) ((k) == MK_ONLY)
#else
#define IN(k) (lo <= (k) && (k) < hi)
#endif
#define SEAM(k) do { if (IN(k) && IN((k) + 1)) { xcd_barrier(bar); if (MK_BAR_TWICE) xcd_barrier(bar); } } while (0)

#ifndef MK_REPEAT
#define MK_REPEAT (-1)
#endif
#define PHASE(k, ...) do { if (IN(k)) { __VA_ARGS__; if (MK_REPEAT == (k) && (k) != 6 && (k) != 9) { xcd_barrier(bar); __VA_ARGS__; } } SEAM(k); } while (0)
    PHASE(0, p0_prep(F));
    PHASE(1, { SchedP1 S{&F, D, D, F.G, F.bid, (const char*)F.xn, (const char*)F.mn, (const char*)F.WinT, (const char*)F.WmkvT};
               EpiP1 E{F.proj, F.kvraw, F.b_gate, F.gate8};
               pg8::gemm_phase<EpiP1, SchedP1>(F.lds, S, E);
               if (P1_FP8_TILES) { SchedP1b S8{&F, D / 2, D / 2, F.G, F.bid, (const char*)F.xn8, (const char*)F.Win8};
                   pg8::gemm_phase<EpiP1, SchedP1b>(F.lds, S8, E); } });
    PHASE(2, p2_prepass(F));
    PHASE(3, p3_attention(F));
    PHASE(4, { SchedP4 S{D, D, F.G, F.bid, (const char*)F.acat, (const char*)F.WcatT};
               EpiP4 E{F.proj, F.mscr, F.merged, F.gate8};
               SchedP4b S8{1536 / 2, 1536 / 2, F.G, F.bid, (const char*)F.acat8, (const char*)F.Wcat8};
               if (P4_FP8 && P4_SMALL_FIRST) pg8::gemm_phase<EpiP4, SchedP4b>(F.lds, S8, E);
               pg8::gemm_phase<EpiP4, SchedP4>(F.lds, S, E);
               if (P4_FP8 && !P4_SMALL_FIRST) pg8::gemm_phase<EpiP4, SchedP4b>(F.lds, S8, E); });
    PHASE(5, { SchedP5 S{D, D, F.G, F.bid, (const char*)F.merged, (const char*)F.WoutT};
               EpiP5 E{F.x, F.out, F.h1b};
               pg8::gemm_phase<EpiP5, SchedP5>(F.lds, S, E); });
    PHASE(6, p6_router(F));
    if (MK_REPEAT == 6) { xcd_barrier(bar); p6_router(F, true); }
    PHASE(7, { moe_tables(F);
               SchedP7 S{XN2_PREGATHER ? 64 : D * MOE_EB / 2, MOE_W_KTILE_MAJOR ? 64 : D * MOE_EB / 2, F.G, F.bid, *(const LAS int*)(F.lds + L_NMB), XN2_PREGATHER ? (const char*)F.xg : (const char*)F.xn2, (const char*)F.WupT, F.list, F.lds};
               EpiP7 E{F.b_up, F.act};
               pg8::gemm_phase<EpiP7, SchedP7>(F.lds, S, E); });
    PHASE(8, { if (!IN(7)) moe_tables(F);
               SchedP8 S{ACT_KTILE_MAJOR ? 64 : DFF * MOE_EB / 2, MOE_W_KTILE_MAJOR ? 64 : DFF * MOE_EB / 2, F.G, F.bid, *(const LAS int*)(F.lds + L_NMB), (const char*)F.act, (const char*)F.WdnT, F.lds};
               EpiP8 E{F.b_dn, F.ybuf};
               pg8::gemm_phase<EpiP8, SchedP8>(F.lds, S, E); });
    PHASE(9, { if (!IN(7)) moe_tables(F); p9_combine(F); });
    if (MK_REPEAT == 9) { xcd_barrier(bar); p9_combine(F, true); }
#undef PHASE
#undef IN
#undef SEAM
}

extern "C" void kernel_launch(void* const* d_in, const int* in_sizes, int n_in, void* d_out, int out_size, void* d_ws, size_t ws_size, hipStream_t stream) {
    static int grid = 0;
    if (grid == 0) {
        if (n_in != 26 || out_size != NTOK * D || ws_size < WS_END) { fprintf(stderr, "kernel_launch: unexpected problem shape (n_in %d, out %d, ws %zu < %zu)\n", n_in, out_size, ws_size, (size_t)WS_END); grid = -1; return; }
        int dev = 0, cus = 0, per_cu = 0;
        if (hipGetDevice(&dev) != hipSuccess || hipDeviceGetAttribute(&cus, hipDeviceAttributeMultiprocessorCount, dev) != hipSuccess) { grid = -1; return; }
        if (hipFuncSetAttribute((const void*)fwd, hipFuncAttributeMaxDynamicSharedMemorySize, LDS_BYTES) != hipSuccess) { fprintf(stderr, "kernel_launch: hipFuncSetAttribute failed\n"); grid = -1; return; }
        if (hipOccupancyMaxActiveBlocksPerMultiprocessor(&per_cu, (const void*)fwd, 512, LDS_BYTES) != hipSuccess || per_cu < 1) { fprintf(stderr, "kernel_launch: occupancy query says %d blocks per CU\n", per_cu); }
        (void)hipGetLastError();
        grid = cus;
    }
    if (grid < 0) return;
    (void)hipMemsetAsync((char*)d_ws + WS_CTL, 0, (size_t)(CW_CNT + 64 * NE) * 4, stream);
    Args a{};
    for (int i = 0; i < 26; ++i) a.in[i] = d_in[i];
    a.out = (float*)d_out; a.ws = (unsigned char*)d_ws;
#if MK_SPLIT
    {
        const Frame F = host_frame(d_in, (float*)d_out, (unsigned char*)d_ws);
        float* a2 = (float*)((unsigned char*)d_ws + WS_ACT);
        if (MK_FAST) { a.ph_lo = 0; a.ph_hi = 1; hipLaunchKernelGGL(fwd, dim3(grid), dim3(512), LDS_BYTES, stream, a); }
        for (int p = 0; p < NPH; ++p) {
            if ((MK_FAST >> p) & 1) { if (p) { a.ph_lo = p; a.ph_hi = p + 1; hipLaunchKernelGGL(fwd, dim3(grid), dim3(512), LDS_BYTES, stream, a); } continue; }
#if MK_NAIVE
            switch (p) {
            case 0: hipLaunchKernelGGL(nv::k_rms, dim3(NTOK), dim3(256), 0, stream, F.x, F.g1, F.xn); hipLaunchKernelGGL(nv::k_rms, dim3(NMEMROW), dim3(256), 0, stream, F.mem, F.gmem, F.mn); break;
            case 1: { nv::PIn pi{F.xn, F.w_in, F.b_gate, F.proj, D}; hipLaunchKernelGGL(nv::k_gemm<nv::PIn>, dim3(IN_W / 64, NTOK / 64, 1), dim3(256), 0, stream, pi);
                      nv::PMkv pm{F.mn, F.w_mkv, F.kvraw, D}; hipLaunchKernelGGL(nv::k_gemm<nv::PMkv>, dim3(1024 / 64, NMEMROW / 64, 1), dim3(256), 0, stream, pm); } break;
            case 2: hipLaunchKernelGGL(nv::k_heads, dim3(NTOK * 14 / 256), dim3(256), 0, stream, F.proj, F.pos, F.gq, F.gk, F.gmq, F.qn, F.kn, F.mqn);
                    hipLaunchKernelGGL(nv::k_memk, dim3(NMEMROW * 4 / 256), dim3(256), 0, stream, F.kvraw, F.gmk, F.mk, F.mvT);
                    hipLaunchKernelGGL(nv::k_vT, dim3(NTOK), dim3(256), 0, stream, F.proj, F.vT);
                    hipLaunchKernelGGL(nv::k_pool, dim3(NTOK * 2), dim3(256), 0, stream, F.proj, F.acat); break;
            case 3: hipLaunchKernelGGL(nv::k_attn, dim3(NTOK * 3), dim3(256), 0, stream, F.qn, F.kn, F.vT, F.mqn, F.mk, F.mvT, F.sink, F.acat); break;
            case 4: { hipLaunchKernelGGL(nv::k_a2, dim3(NTOK * 2), dim3(256), 0, stream, F.acat, F.w_pg, F.pool_scale, a2);
                      nv::PBr b0{a2, nullptr, 512, 0, F.w_pp, F.proj, F.mscr, F.merged, 0, 512}; hipLaunchKernelGGL(nv::k_gemm<nv::PBr>, dim3(D / 64, NTOK / 64, 1), dim3(256), 0, stream, b0);
                      nv::PBr b1{nullptr, F.acat, D, 512, F.w_ap, F.proj, F.mscr, F.merged, 1, 1024}; hipLaunchKernelGGL(nv::k_gemm<nv::PBr>, dim3(D / 64, NTOK / 64, 1), dim3(256), 0, stream, b1);
                      nv::PBr b2{nullptr, F.acat, D, 1536, F.w_mp, F.proj, F.mscr, F.merged, 2, 512}; hipLaunchKernelGGL(nv::k_gemm<nv::PBr>, dim3(D / 64, NTOK / 64, 1), dim3(256), 0, stream, b2); } break;
            case 5: { nv::POut po{F.merged, F.w_out, F.x, F.out, D}; hipLaunchKernelGGL(nv::k_gemm<nv::POut>, dim3(D / 64, NTOK / 64, 1), dim3(256), 0, stream, po); } break;
            case 6: hipLaunchKernelGGL(nv::k_router, dim3(NTOK / 4), dim3(256), 0, stream, F.out, F.g2, F.w_r, F.b_r, F.xn2, F.ctl, F.list, F.er, F.tw); break;
            case 7: { nv::PUp pu{F.xn2, F.list, F.ctl, F.w_up, F.b_up, F.act, D}; hipLaunchKernelGGL(nv::k_gemm<nv::PUp>, dim3(2 * DFF / 64, NTOK / 64, NE), dim3(256), 0, stream, pu); } break;
            case 8: { nv::PDn pd{F.act, F.ctl, F.w_dn, F.b_dn, F.ybuf, DFF}; hipLaunchKernelGGL(nv::k_gemm<nv::PDn>, dim3(D / 64, NTOK / 64, NE), dim3(256), 0, stream, pd); } break;
            case 9: hipLaunchKernelGGL(nv::k_combine, dim3(NTOK), dim3(256), 0, stream, F.ctl, F.er, F.tw, F.ybuf, F.out); break;
            }
#endif
        }
    }
#else
    a.ph_lo = 0; a.ph_hi = NPH; hipLaunchKernelGGL(fwd, dim3(grid), dim3(512), LDS_BYTES, stream, a);
#endif
}
```
